# Optimizing an MI355X kernel written in HIP

```python
import jax, jax.numpy as jnp
from jax import lax
import numpy as np

D_MODEL = 2048
BATCH = 8
SEQ = 2048
DEPTH = 1

D_MIX = D_MODEL
D_ATT = D_MIX // 2
D_RNN = D_MIX - D_ATT
N_Q_HEADS = 16
N_KV_GROUPS = 4
HEADS_PER_GROUP = N_Q_HEADS // N_KV_GROUPS
HEAD_DIM = D_ATT // N_Q_HEADS
D_KV = N_KV_GROUPS * HEAD_DIM
CMP_BLOCK = 32
CMP_STRIDE = 16
CMP_HIDDEN = 4 * HEAD_DIM
SEL_BLOCK = 64
SEL_TOP_N = 8
WINDOW = 512
Q_CHUNK = 128
N_BRANCH = 3
RNN_BLOCKS = 8
RNN_BLOCK_DIM = D_RNN // RNN_BLOCKS
CONV_WIDTH = 4
LRU_C = 8.0
D_FF = 4 * D_MODEL
EPS = 1e-6
NEG = -1e30
FORCE_SCORE = 1e9

SPLIT_SIZES = [D_ATT] + [D_KV] * 6 + [N_BRANCH * N_Q_HEADS, D_RNN, D_RNN]
D_IN = sum(SPLIT_SIZES)
SPLIT_POINTS = [int(v) for v in np.cumsum(SPLIT_SIZES)[:-1]]

kernel_name = "hymba_nsa_rglru_sandwich_adaln_block"


def rms_norm(x, g):
    xf = x.astype(jnp.float32)
    y = xf * lax.rsqrt(jnp.mean(xf * xf, axis=-1, keepdims=True) + EPS)
    return (y * g.astype(jnp.float32)).astype(x.dtype)


def masked_softmax(s, mask):
    p = jax.nn.softmax(jnp.where(mask, s.astype(jnp.float32), NEG), axis=-1)
    return jnp.where(mask, p, 0.0)


def compress_kv(k, w1, w2, pe):
    B, S = k.shape[0], k.shape[1]
    n_cmp = (S - CMP_BLOCK) // CMP_STRIDE + 1
    idx = jnp.arange(n_cmp)[:, None] * CMP_STRIDE + jnp.arange(CMP_BLOCK)[None, :]
    blk = k[:, idx] + pe[None, None, :, None, :]
    blk = jnp.moveaxis(blk, 2, 3).reshape(B, n_cmp, N_KV_GROUPS, CMP_BLOCK * HEAD_DIM)
    return jax.nn.gelu(blk @ w1) @ w2


def cmp_to_sel_weights(n_cmp, n_sel):
    c0 = np.arange(n_cmp)[:, None] * CMP_STRIDE
    s0 = np.arange(n_sel)[None, :] * SEL_BLOCK
    ov = np.minimum(c0 + CMP_BLOCK, s0 + SEL_BLOCK) - np.maximum(c0, s0)
    return jnp.asarray(np.clip(ov, 0, None).astype(np.float32) / CMP_BLOCK)


def nsa_attention(q, kc, vc, ks, vs, kw, vw, gate_logits, w1k, w2k, pek, w1v, w2v, pev):
    B, S = q.shape[0], q.shape[1]
    G, Hg, Dh = N_KV_GROUPS, HEADS_PER_GROUP, HEAD_DIM
    q = q.reshape(B, S, G, Hg, Dh) * (Dh ** -0.5)
    kc, vc, ks, vs, kw, vw = [t.reshape(B, S, G, Dh) for t in (kc, vc, ks, vs, kw, vw)]
    pos = jnp.arange(S)

    k_cmp = compress_kv(kc, w1k, w2k, pek)
    v_cmp = compress_kv(vc, w1v, w2v, pev)
    n_cmp = k_cmp.shape[1]
    cmp_end = jnp.arange(n_cmp) * CMP_STRIDE + CMP_BLOCK - 1
    mask_c = (cmp_end[None, :] <= pos[:, None])[None, :, None, None, :]
    s_c = jnp.einsum('bsghd,bngd->bsghn', q, k_cmp)
    p_c = masked_softmax(s_c, mask_c)
    o_cmp = jnp.einsum('bsghn,bngd->bsghd', p_c.astype(v_cmp.dtype), v_cmp)

    n_sel = S // SEL_BLOCK
    imp = jnp.einsum('bsghn,nj->bsgj', p_c, cmp_to_sel_weights(n_cmp, n_sel))
    blk = jnp.arange(n_sel)[None, :]
    cur = (pos // SEL_BLOCK)[:, None]
    forced = (blk == 0) | (blk == cur) | (blk == cur - 1)
    valid = blk * SEL_BLOCK <= pos[:, None]
    imp = jnp.where(forced[None, :, None, :], FORCE_SCORE,
                    jnp.where(valid[None, :, None, :], imp, -FORCE_SCORE))
    top_n = min(SEL_TOP_N, n_sel)
    _, sel_idx = lax.top_k(imp, top_n)

    ks_blk = ks.reshape(B, n_sel, SEL_BLOCK, G, Dh).transpose(0, 3, 1, 2, 4)
    vs_blk = vs.reshape(B, n_sel, SEL_BLOCK, G, Dh).transpose(0, 3, 1, 2, 4)
    kw_pad = jnp.pad(kw, ((0, 0), (WINDOW, 0), (0, 0), (0, 0)))
    vw_pad = jnp.pad(vw, ((0, 0), (WINDOW, 0), (0, 0), (0, 0)))
    b_ix = jnp.arange(B)[:, None, None, None]
    g_ix = jnp.arange(G)[None, None, :, None]
    n_keys_sel = top_n * SEL_BLOCK

    def query_block(ci):
        start = ci * Q_CHUNK
        tq = start + jnp.arange(Q_CHUNK)
        qc = lax.dynamic_slice_in_dim(q, start, Q_CHUNK, axis=1)
        idx = lax.dynamic_slice_in_dim(sel_idx, start, Q_CHUNK, axis=1)
        k_sel = ks_blk[b_ix, g_ix, idx].reshape(B, Q_CHUNK, G, n_keys_sel, Dh)
        v_sel = vs_blk[b_ix, g_ix, idx].reshape(B, Q_CHUNK, G, n_keys_sel, Dh)
        kpos = (idx[..., None] * SEL_BLOCK + jnp.arange(SEL_BLOCK)).reshape(B, Q_CHUNK, G, n_keys_sel)
        mask_s = (kpos <= tq[None, :, None, None])[:, :, :, None, :]
        p_s = masked_softmax(jnp.einsum('bcghd,bcgnd->bcghn', qc, k_sel), mask_s)
        o_s = jnp.einsum('bcghn,bcgnd->bcghd', p_s.astype(v_sel.dtype), v_sel)
        k_w = lax.dynamic_slice_in_dim(kw_pad, start, Q_CHUNK + WINDOW, axis=1)
        v_w = lax.dynamic_slice_in_dim(vw_pad, start, Q_CHUNK + WINDOW, axis=1)
        wpos = start - WINDOW + jnp.arange(Q_CHUNK + WINDOW)
        mask_w = ((wpos[None, :] <= tq[:, None]) & (wpos[None, :] > tq[:, None] - WINDOW)
                  & (wpos[None, :] >= 0))[None, :, None, None, :]
        p_w = masked_softmax(jnp.einsum('bcghd,bkgd->bcghk', qc, k_w), mask_w)
        o_w = jnp.einsum('bcghk,bkgd->bcghd', p_w.astype(v_w.dtype), v_w)
        return o_s, o_w

    o_sel, o_win = lax.map(query_block, jnp.arange(S // Q_CHUNK))
    o_sel = jnp.moveaxis(o_sel, 0, 1).reshape(B, S, G, Hg, Dh)
    o_win = jnp.moveaxis(o_win, 0, 1).reshape(B, S, G, Hg, Dh)

    g = jax.nn.sigmoid(gate_logits).reshape(B, S, G, Hg, N_BRANCH)
    o = g[..., 0:1] * o_cmp + g[..., 1:2] * o_sel + g[..., 2:3] * o_win
    return o.reshape(B, S, D_ATT)


def causal_depthwise_conv(x, w, b):
    S = x.shape[1]
    xp = jnp.pad(x, ((0, 0), (CONV_WIDTH - 1, 0), (0, 0)))
    return b + sum(xp[:, k:k + S] * w[k] for k in range(CONV_WIDTH))


def block_diag_linear(x, w, b):
    B, S = x.shape[0], x.shape[1]
    xb = x.reshape(B, S, RNN_BLOCKS, RNN_BLOCK_DIM)
    return jnp.einsum('bsni,nij->bsnj', xb, w).reshape(B, S, D_RNN) + b


def rg_lru(x, w_a, b_a, w_x, b_x, lam):
    xf = x.astype(jnp.float32)
    r = jax.nn.sigmoid(block_diag_linear(x, w_a, b_a).astype(jnp.float32))
    i = jax.nn.sigmoid(block_diag_linear(x, w_x, b_x).astype(jnp.float32))
    log_a = -LRU_C * r * jax.nn.softplus(-lam.astype(jnp.float32))
    a = jnp.exp(log_a)
    bterm = jnp.sqrt(-jnp.expm1(2.0 * log_a)) * (i * xf)

    def combine(lhs, rhs):
        a1, b1 = lhs
        a2, b2 = rhs
        return a1 * a2, a2 * b1 + b2

    _, h = lax.associative_scan(combine, (a, bterm), axis=1)
    return h.astype(x.dtype)


def setup_inputs(seed: int = 0) -> dict:
    key = jax.random.key(seed)
    ks = jax.random.split(key, 32)
    nrm = lambda k, shape, s: jax.random.normal(k, shape, jnp.float32) * s
    L = DEPTH
    u = jax.random.uniform(ks[21], (L, D_RNN), jnp.float32, 0.9, 0.999)
    a0 = u ** (1.0 / LRU_C)
    return {
        "x": nrm(ks[0], (BATCH, SEQ, D_MODEL), 1.0),
        "c": nrm(ks[1], (BATCH, D_MODEL), 1.0),
        "w_ada": nrm(ks[2], (L, D_MODEL, 6 * D_MODEL), D_MODEL ** -0.5),
        "b_ada": nrm(ks[3], (L, 6 * D_MODEL), 0.01),
        "g_pre_mix": 1.0 + nrm(ks[4], (L, D_MODEL), 0.01),
        "g_post_mix": 1.0 + nrm(ks[5], (L, D_MODEL), 0.01),
        "g_pre_mlp": 1.0 + nrm(ks[6], (L, D_MODEL), 0.01),
        "g_post_mlp": 1.0 + nrm(ks[7], (L, D_MODEL), 0.01),
        "w_in": nrm(ks[8], (L, D_MODEL, D_IN), D_MODEL ** -0.5),
        "cmp_w1_k": nrm(ks[9], (L, CMP_BLOCK * HEAD_DIM, CMP_HIDDEN), (CMP_BLOCK * HEAD_DIM) ** -0.5),
        "cmp_w2_k": nrm(ks[10], (L, CMP_HIDDEN, HEAD_DIM), CMP_HIDDEN ** -0.5),
        "cmp_pe_k": nrm(ks[11], (L, CMP_BLOCK, HEAD_DIM), 0.1),
        "cmp_w1_v": nrm(ks[12], (L, CMP_BLOCK * HEAD_DIM, CMP_HIDDEN), (CMP_BLOCK * HEAD_DIM) ** -0.5),
        "cmp_w2_v": nrm(ks[13], (L, CMP_HIDDEN, HEAD_DIM), CMP_HIDDEN ** -0.5),
        "cmp_pe_v": nrm(ks[14], (L, CMP_BLOCK, HEAD_DIM), 0.1),
        "conv_w": nrm(ks[15], (L, CONV_WIDTH, D_RNN), CONV_WIDTH ** -0.5),
        "conv_b": nrm(ks[16], (L, D_RNN), 0.01),
        "w_rg_a": nrm(ks[17], (L, RNN_BLOCKS, RNN_BLOCK_DIM, RNN_BLOCK_DIM), RNN_BLOCK_DIM ** -0.5),
        "b_rg_a": nrm(ks[18], (L, D_RNN), 0.01),
        "w_rg_x": nrm(ks[19], (L, RNN_BLOCKS, RNN_BLOCK_DIM, RNN_BLOCK_DIM), RNN_BLOCK_DIM ** -0.5),
        "b_rg_x": nrm(ks[20], (L, D_RNN), 0.01),
        "lru_lambda": jnp.log(a0) - jnp.log1p(-a0),
        "g_grp_att": 1.0 + nrm(ks[22], (L, D_ATT), 0.01),
        "g_grp_rnn": 1.0 + nrm(ks[23], (L, D_RNN), 0.01),
        "w_out": nrm(ks[24], (L, D_MIX, D_MODEL), D_MIX ** -0.5),
        "w_ff1": nrm(ks[25], (L, D_MODEL, D_FF), D_MODEL ** -0.5),
        "w_ff2": nrm(ks[26], (L, D_FF, D_MODEL), D_FF ** -0.5),
    }


def reference(x, c, w_ada, b_ada, g_pre_mix, g_post_mix, g_pre_mlp, g_post_mlp, w_in,
              cmp_w1_k, cmp_w2_k, cmp_pe_k, cmp_w1_v, cmp_w2_v, cmp_pe_v,
              conv_w, conv_b, w_rg_a, b_rg_a, w_rg_x, b_rg_x, lru_lambda,
              g_grp_att, g_grp_rnn, w_out, w_ff1, w_ff2):
    c_act = jax.nn.silu(c)
    for l in range(DEPTH):
        mod = c_act @ w_ada[l] + b_ada[l]
        sh1, sc1, gt1, sh2, sc2, gt2 = [m[:, None, :] for m in jnp.split(mod, 6, axis=-1)]

        h = rms_norm(x, g_pre_mix[l]) * (1.0 + sc1) + sh1
        proj = h @ w_in[l]
        q, kc, vc, ksl, vsl, kw, vw, gl, xr, yr = jnp.split(proj, SPLIT_POINTS, axis=-1)
        o_att = nsa_attention(q, kc, vc, ksl, vsl, kw, vw, gl,
                              cmp_w1_k[l], cmp_w2_k[l], cmp_pe_k[l],
                              cmp_w1_v[l], cmp_w2_v[l], cmp_pe_v[l])
        xr = causal_depthwise_conv(xr, conv_w[l], conv_b[l])
        hr = rg_lru(xr, w_rg_a[l], b_rg_a[l], w_rg_x[l], b_rg_x[l], lru_lambda[l])
        o_rnn = jax.nn.gelu(yr) * hr
        mix = jnp.concatenate([rms_norm(o_att, g_grp_att[l]),
                               rms_norm(o_rnn, g_grp_rnn[l])], axis=-1) @ w_out[l]
        x = x + gt1 * rms_norm(mix, g_post_mix[l])

        h = rms_norm(x, g_pre_mlp[l]) * (1.0 + sc2) + sh2
        f = jnp.square(jax.nn.relu(h @ w_ff1[l])) @ w_ff2[l]
        x = x + gt2 * rms_norm(f, g_post_mlp[l])
    return x
```

```cpp
#include <hip/hip_runtime.h>
#include <cstdio>
#include <cstdint>

#ifndef MK_N_LAUNCHES
#define MK_N_LAUNCHES 1
#endif

#ifndef PROBE_REP
#define PROBE_REP 0
#endif
#ifndef PROBE_TM
#define PROBE_TM 0
#endif
#ifndef PROBE_P0X
#define PROBE_P0X 0
#endif
#ifndef PROBE_BAR
#define PROBE_BAR 0
#endif
#ifndef PROBE_ATTP
#define PROBE_ATTP 0
#endif
#ifndef PROBE_SCAN
#define PROBE_SCAN 0
#endif
#ifndef PROBE_AV
#define PROBE_AV 0
#endif
#ifndef PROBE_ATT
#define PROBE_ATT 0
#endif
#define GAS __attribute__((address_space(1)))
#define LAS __attribute__((address_space(3)))
typedef _Float16 half_t;
typedef _Float16 half8 __attribute__((ext_vector_type(8)));
typedef _Float16 half4 __attribute__((ext_vector_type(4)));
typedef _Float16 half2v __attribute__((ext_vector_type(2)));
typedef float f32x4 __attribute__((ext_vector_type(4)));
typedef float f32x2 __attribute__((ext_vector_type(2)));
typedef unsigned u32x4 __attribute__((ext_vector_type(4)));
typedef unsigned u32x2 __attribute__((ext_vector_type(2)));

constexpr int NB = 8, SEQ = 2048, NTOK = NB * SEQ, DM = 2048, DFF = 8192;
constexpr int NPROJ = 4656, NP = 4864;
constexpr int PC_Q = 0, PC_KC = 1024, PC_VC = 1280, PC_KS = 1536, PC_VS = 1792, PC_KW = 2048, PC_VW = 2304, PC_XR = 2560, PC_YR = 3584, PC_GL = 4608;
constexpr float EPS = 1e-6f;
#ifndef FFN_BF16
#define FFN_BF16 1
#endif
constexpr int FFN_DT = FFN_BF16;
constexpr int PROJ_DT = 1;
constexpr float QSC = 0.125f * 1.4426950408889634f;

constexpr size_t MiB = 1u << 20;
constexpr size_t WS_CTL = 0, CTL_ZERO_BYTES = 1 * MiB;
constexpr size_t WS_MOD = 1 * MiB;
constexpr size_t WS_SELMASK = 1 * MiB + 512 * 1024;
constexpr size_t WS_SP8 = 1 * MiB + 448 * 1024;
constexpr size_t WS_KCMP = 2 * MiB;
constexpr size_t WS_VCMP = 2 * MiB + 512 * 1024;
constexpr size_t WS_WFF2 = 4 * MiB;
constexpr size_t WS_WFF1 = 36 * MiB;
constexpr size_t WS_WIN = 68 * MiB;
constexpr size_t WS_WOUT = 87 * MiB;
constexpr size_t WS_WC1 = 95 * MiB;
constexpr size_t WS_WRG = 97 * MiB;
constexpr size_t WS_HBUF = 100 * MiB;
constexpr size_t WS_P = 164 * MiB;
constexpr size_t WS_XC = 317 * MiB;
constexpr size_t WS_HID = 349 * MiB;
constexpr size_t WS_ABUF = 353 * MiB;
constexpr size_t WS_BTBUF = 417 * MiB;
constexpr size_t WS_MIXBUF = 164 * MiB;
constexpr size_t WS_U = 68 * MiB;
constexpr size_t WS_AMIX = 100 * MiB;
constexpr size_t WS_H2 = 356 * MiB;
constexpr size_t WS_FBUF = 36 * MiB;
constexpr size_t WS_X1H = 420 * MiB;
constexpr size_t WS_XSLOT = 484 * MiB;
constexpr size_t WS_PAR = 3 * MiB;
constexpr size_t WS_SLAB = 486 * MiB;
constexpr size_t WS_END = 502 * MiB;
constexpr int CW_TMO = 0;
constexpr int CW_BAR = 4096;
constexpr int CW_BIAS1 = 16384;
constexpr int CW_SSA = 65536, CW_SSR = 81920;
constexpr int CW_P2CNT = 24576;
constexpr int CW_P1Q = 27648;
constexpr int CW_P0Q = 28160;
constexpr int CW_ATTQ = 28672;
constexpr int CW_PANEL = 32768;

#define RLX_AGENT __ATOMIC_RELAXED, __HIP_MEMORY_SCOPE_AGENT
#define LDS_WAIT() asm volatile("s_waitcnt lgkmcnt(0)" ::: "memory")
#define VM_WAIT() asm volatile("s_waitcnt vmcnt(0)" ::: "memory")
typedef GAS unsigned gu32;

__device__ __forceinline__ unsigned pk2h(float lo, float hi) { f32x2 v = {lo, hi}; half2v h = __builtin_convertvector(v, half2v); return __builtin_bit_cast(unsigned, h); }
typedef __bf16 bf16x2_t __attribute__((ext_vector_type(2)));
typedef short bf16x8 __attribute__((ext_vector_type(8)));
__device__ __forceinline__ unsigned pk2b(float lo, float hi) { f32x2 v = {lo, hi}; bf16x2_t b = __builtin_convertvector(v, bf16x2_t); return __builtin_bit_cast(unsigned, b); }
template <int DT> __device__ __forceinline__ unsigned pk2x(float lo, float hi) { return DT ? pk2b(lo, hi) : pk2h(lo, hi); }
__device__ __forceinline__ float wave_sum(float v) {
#pragma unroll
    for (int o = 1; o < 64; o <<= 1) v += __shfl_xor(v, o);
    return v;
}
__device__ __forceinline__ float fast_exp(float x) { return __builtin_amdgcn_exp2f(x * 1.4426950408889634f); }
__device__ __forceinline__ float sigmoidf_(float x) { return __builtin_amdgcn_rcpf(1.0f + fast_exp(-x)); }
__device__ __forceinline__ float gelu_tanh(float x) {
    const float u = 1.5957691216057308f * (x + 0.044715f * x * x * x);
    return x * __builtin_amdgcn_rcpf(1.0f + fast_exp(-u));
}
__device__ __forceinline__ float siluf_(float x) { return x / (1.0f + __expf(-x)); }

__device__ __forceinline__ int lane_id() { int l; asm volatile("v_mbcnt_lo_u32_b32 %0, -1, 0\n\tv_mbcnt_hi_u32_b32 %0, -1, %0" : "=v"(l)); return l; }
__device__ __forceinline__ int make_tid(int wv) { return wv * 64 + lane_id(); }

namespace pg8 {
constexpr int XTAB_OFF = 131072 + 1024;
constexpr int BM = 256, BK = 64, HALF = 128, HTB = HALF * BK * 2, STAGE_BYTES = 8 * HTB, NXCD = 8, WGM = 8;
__host__ __device__ __forceinline__ int lds_byte(int r, int c) { const int st = (r >> 4) * 2 + (c >> 5), rr = r & 15, cc = c & 31, ob = rr * 64 + cc * 2; return st * 1024 + (ob ^ (((ob >> 9) & 1) << 5)); }
__host__ __device__ __forceinline__ void stage_rc(int b, int& R, int& C) { const int st = b / 1024, sb = b % 1024, swz = sb ^ (((sb >> 9) & 1) << 5); R = (st >> 1) * 16 + swz / 64; C = (st & 1) * 32 + (swz % 64) / 2; }
__host__ __device__ __forceinline__ int perm32(int rho) { const int n = rho >> 4, i = rho & 15; return 8 * (i >> 2) + 4 * n + (i & 3); }

struct Unit { int pm, pn; };

struct StaticOrder {
    int nM, nN, nwg, G, c;
    __device__ void init(int nM_, int nN_, int G_, int c_) { nM = nM_; nN = nN_; nwg = nM * nN; G = G_; c = c_; }
    __device__ bool next(int i, Unit& u) const {
        const long L = (long)i * G + c; if (L >= nwg) return false;
        int wgid = (int)L; { const int q = nwg / NXCD, r = nwg % NXCD, xcd = wgid % NXCD, off = wgid / NXCD; wgid = (xcd < r ? xcd * (q + 1) : r * (q + 1) + (xcd - r) * q) + off; }
        const int nig = WGM * nN, gid = wgid / nig, fm = gid * WGM, gsz = (nM - fm) < WGM ? (nM - fm) : WGM;
        u.pm = fm + ((wgid % nig) % gsz); u.pn = (wgid % nig) / gsz; return true;
    }
};

struct GeoPlain {
    const half_t* A; const half_t* Bt; int lda, K;
    __device__ __forceinline__ int nt() const { return K / BK; }
    __device__ __forceinline__ unsigned voffA(int R, int C) const { return (unsigned)(R * lda + C) * 2u; }
    __device__ __forceinline__ size_t kstepA() const { return (size_t)BK * 2; }
    __device__ __forceinline__ size_t hstepA() const { return (size_t)HALF * lda * 2; }
    __device__ __forceinline__ const char* a_base(const Unit& u) const { return (const char*)A + (size_t)u.pm * BM * lda * 2; }
    __device__ __forceinline__ int ldb() const { return K; }
    __device__ __forceinline__ const char* b_base(const Unit& u) const { return (const char*)Bt + (size_t)u.pn * BM * K * 2; }
};
struct GeoGates {
    const half_t* A; const half_t* Bt;
    __device__ __forceinline__ int nt() const { return 2; }
    __device__ __forceinline__ unsigned voffA(int R, int C) const { return (unsigned)(R * 1024 + C) * 2u; }
    __device__ __forceinline__ size_t kstepA() const { return (size_t)BK * 2; }
    __device__ __forceinline__ size_t hstepA() const { return (size_t)HALF * 1024 * 2; }
    __device__ __forceinline__ const char* a_base(const Unit& u) const { return (const char*)A + ((size_t)u.pm * BM * 1024 + (size_t)u.pn * 128) * 2; }
    __device__ __forceinline__ int ldb() const { return 128; }
    __device__ __forceinline__ const char* b_base(const Unit& u) const { return (const char*)Bt + (size_t)u.pn * BM * 128 * 2; }
};
struct GeoCmp {
    const half_t* P; const half_t* Bt;
    __device__ __forceinline__ int nt() const { return 16; }
    __device__ __forceinline__ unsigned voffA(int R, int C) const { return (unsigned)((16 * (R >> 2)) * NP + (R & 3) * 64 + C) * 2u; }
    __device__ __forceinline__ size_t kstepA() const { return (size_t)NP * 2; }
    __device__ __forceinline__ size_t hstepA() const { return (size_t)(16 * 32) * NP * 2; }
    __device__ __forceinline__ const char* a_base(const Unit& u) const { const int b = u.pm >> 1, nb = (u.pm & 1) * 64, kv = u.pn & 1, ks = u.pn >> 1; return (const char*)P + ((size_t)(b * SEQ + 16 * nb + 16 * ks) * NP + (kv ? PC_VC : PC_KC)) * 2; }
    __device__ __forceinline__ int ldb() const { return 2048; }
    __device__ __forceinline__ const char* b_base(const Unit& u) const { const int kv = u.pn & 1, ks = u.pn >> 1; return (const char*)Bt + ((size_t)kv * BM * 2048 + (size_t)ks * 1024) * 2; }
};

template <int ACT  , int DT = 0  > struct EpiF16 {
    static constexpr bool PERM = true;
    half_t* O; int ldc; const float* bias;
    __device__ __forceinline__ void operator()(const f32x4 (&acc)[2][2][4][2], const Unit& u, int wr, int wc, int fr, int fq) const {
        const int row0 = u.pm * BM + wr * 64 + fr; const int col0 = u.pn * BM + wc * 32 + 8 * fq;
        f32x4 bv[2][2];
#pragma unroll
        for (int bj = 0; bj < 2; ++bj)
#pragma unroll
            for (int n = 0; n < 2; ++n) bv[bj][n] = (ACT == 2) ? *(const f32x4*)(bias + col0 + bj * HALF + 4 * n) : (f32x4){0.f, 0.f, 0.f, 0.f};
#pragma unroll
        for (int ai = 0; ai < 2; ++ai)
#pragma unroll
            for (int m = 0; m < 4; ++m) { half_t* rowp = O + (size_t)(row0 + ai * HALF + m * 16) * ldc + col0;
#pragma unroll
                for (int bj = 0; bj < 2; ++bj) { f32x4 v0 = acc[ai][bj][m][0] + bv[bj][0], v1 = acc[ai][bj][m][1] + bv[bj][1];
                    if (ACT == 1) {
#pragma unroll
                        for (int e = 0; e < 4; ++e) { const float a = fmaxf(v0[e], 0.f), b = fmaxf(v1[e], 0.f); v0[e] = a * a; v1[e] = b * b; } }
                    if (ACT == 2) {
#pragma unroll
                        for (int e = 0; e < 4; ++e) { v0[e] = gelu_tanh(v0[e]); v1[e] = gelu_tanh(v1[e]); } }
                    if (ACT == 3) { if (u.pn < 4) { v0 = v0 * QSC; v1 = v1 * QSC; } }
                    u32x4 w; w.x = pk2x<DT>(v0[0], v0[1]); w.y = pk2x<DT>(v0[2], v0[3]); w.z = pk2x<DT>(v1[0], v1[1]); w.w = pk2x<DT>(v1[2], v1[3]);
                    *(u32x4*)(rowp + bj * HALF) = w; } }
    }
};
struct EpiF32 {
    static constexpr bool PERM = false;
    float* C; int ldc;
    __device__ __forceinline__ void operator()(const f32x4 (&acc)[2][2][4][2], const Unit& u, int wr, int wc, int fr, int fq) const {
        const int row0 = u.pm * BM + wr * 64 + fr, col0 = u.pn * BM + wc * 32 + 4 * fq;
#pragma unroll
        for (int ai = 0; ai < 2; ++ai)
#pragma unroll
            for (int m = 0; m < 4; ++m) { float* rowp = C + (size_t)(row0 + ai * HALF + m * 16) * ldc + col0;
#pragma unroll
                for (int bj = 0; bj < 2; ++bj)
#pragma unroll
                    for (int n = 0; n < 2; ++n) *(f32x4*)(rowp + bj * HALF + n * 16) = acc[ai][bj][m][n]; }
    }
};
struct EpiSlab {
    static constexpr bool PERM = false;
    float* C;
    __device__ __forceinline__ void operator()(const f32x4 (&acc)[2][2][4][2], const Unit& u, int wr, int wc, int fr, int fq) const {
        const int row0 = u.pm * BM + wr * 64 + fr, col0 = (u.pn & 1) * BM + wc * 32 + 4 * fq; float* base = C + (size_t)(u.pn >> 1) * 4096 * 512;
#pragma unroll
        for (int ai = 0; ai < 2; ++ai)
#pragma unroll
            for (int m = 0; m < 4; ++m) { float* rowp = base + (size_t)(row0 + ai * HALF + m * 16) * 512 + col0;
#pragma unroll
                for (int bj = 0; bj < 2; ++bj)
#pragma unroll
                    for (int n = 0; n < 2; ++n) *(f32x4*)(rowp + bj * HALF + n * 16) = acc[ai][bj][m][n]; }
    }
};
struct EpiGates {
    static constexpr bool PERM = false;
    const half_t* xc; const LAS float* tab; unsigned* ab;
    __device__ __forceinline__ void operator()(const f32x4 (&acc)[2][2][4][2], const Unit& u, int wr, int wc, int fr, int fq) const {
        const int row0 = u.pm * BM + wr * 64 + fr, ch0 = u.pn * 128 + wc * 32 + 4 * fq;
        half4 xnext = *(const half4*)(xc + (unsigned)row0 * 1024u + ch0);
#pragma unroll
        for (int k = 0; k < 16; ++k) { const int ai = k >> 3, m = (k >> 1) & 3, n = k & 1; const unsigned rowo = (unsigned)(row0 + ai * HALF + m * 16) * 1024u; const int ch = ch0 + n * 16;
            const half4 xh = xnext;
            if (k < 15) { const int k1 = k + 1; xnext = *(const half4*)(xc + (unsigned)(row0 + (k1 >> 3) * HALF + ((k1 >> 1) & 3) * 16) * 1024u + ch0 + (k1 & 1) * 16); }
            const f32x4 ba = *(const LAS f32x4*)(tab + ch), bx = *(const LAS f32x4*)(tab + 1024 + ch), sp = *(const LAS f32x4*)(tab + 2048 + ch);
            __builtin_amdgcn_sched_barrier(0);
            u32x4 pk;
#pragma unroll
            for (int e = 0; e < 4; ++e) { const float r = sigmoidf_(acc[ai][0][m][n][e] + ba[e]), ig = sigmoidf_(acc[ai][1][m][n][e] + bx[e]);
                const float a = __builtin_amdgcn_exp2f(-(r * sp[e]) * 1.4426950408889634f), om = 1.0f - a;
                pk[e] = pk2h(om, __builtin_amdgcn_sqrtf(om * (1.0f + a)) * (ig * (float)xh[e])); }
            *(u32x4*)(ab + rowo + ch) = pk;
            if (n == 1) { asm volatile("" ::: "memory"); __builtin_amdgcn_sched_barrier(0); } }
    }
};

struct PanelOrder {
    int v;
    __device__ bool next(int i, Unit& u) const { if (i >= 2) return false; u.pm = i * 32 + (v >> 3); u.pn = v & 7; return true; }
};
struct PanelXchg {
    float* slots;
    unsigned* cnt;
    __device__ __forceinline__ void run(const f32x4 (&v)[2][2][4][2], const Unit& u, int wr, int wc, int fr, int fq, LAS unsigned char* tab, int wid, int lane) const {
        LAS float* Pt = (LAS float*)tab; LAS float* St = (LAS float*)(tab + 4096);
#pragma unroll
        for (int ai = 0; ai < 2; ++ai)
#pragma unroll
            for (int m = 0; m < 4; ++m) { float s = 0.f;
#pragma unroll
                for (int bj = 0; bj < 2; ++bj)
#pragma unroll
                    for (int n = 0; n < 2; ++n) { const f32x4 x = v[ai][bj][m][n]; s += (x[0] * x[0] + x[1] * x[1]) + (x[2] * x[2] + x[3] * x[3]); }
                s += __shfl_xor(s, 16); s += __shfl_xor(s, 32);
                if (fq == 0) Pt[(ai * HALF + wr * 64 + m * 16 + fr) * 4 + wc] = s; }
        asm volatile("s_waitcnt lgkmcnt(0)" ::: "memory"); __builtin_amdgcn_s_barrier(); asm volatile("" ::: "memory");
        const int row = wid * 32 + (lane & 31);
        if (lane < 32) { const float tot = (Pt[row * 4 + 0] + Pt[row * 4 + 1]) + (Pt[row * 4 + 2] + Pt[row * 4 + 3]);
            __hip_atomic_store(slots + ((size_t)(u.pm * BM + row) * 8 + u.pn), tot, __ATOMIC_RELAXED, __HIP_MEMORY_SCOPE_AGENT); }
        asm volatile("s_waitcnt vmcnt(0)" ::: "memory");
        if (lane == 0) __hip_atomic_fetch_add(cnt + 64 * u.pm, 1u, __ATOMIC_RELAXED, __HIP_MEMORY_SCOPE_AGENT);
        if (wid == 0) {
            unsigned sp = 0;
            while ((unsigned)__builtin_amdgcn_readfirstlane(__hip_atomic_load(cnt + 64 * u.pm, __ATOMIC_RELAXED, __HIP_MEMORY_SCOPE_AGENT)) < 64u) { __builtin_amdgcn_s_sleep(2); if (++sp > (1u << 22)) break; }
            __builtin_amdgcn_fence(__ATOMIC_ACQUIRE, "agent");
        }
        asm volatile("s_waitcnt vmcnt(0) lgkmcnt(0)" ::: "memory"); __builtin_amdgcn_s_barrier(); asm volatile("" ::: "memory");
        if (lane < 32) { const float* sl = slots + (size_t)(u.pm * BM + row) * 8; f32x4 sa, sb;
            asm volatile("global_load_dwordx4 %0, %2, off sc1\n\tglobal_load_dwordx4 %1, %2, off offset:16 sc1\n\ts_waitcnt vmcnt(0)" : "=&v"(sa), "=&v"(sb) : "v"(sl) : "memory");
            St[row] = ((sa.x + sa.y) + (sa.z + sa.w)) + ((sb.x + sb.y) + (sb.z + sb.w)); }
        asm volatile("s_waitcnt lgkmcnt(0)" ::: "memory"); __builtin_amdgcn_s_barrier(); asm volatile("" ::: "memory");
    }
};
struct EpiX1H2 {
    static constexpr bool PERM = true, FUSED = true, HAS_MID = true;
    const float* par; half_t* x1h; half_t* h2; PanelXchg x1, x2;
    const float* ssa; const float* ssr;
    __device__ __forceinline__ void unit_begin(const Unit& u, LAS unsigned char* tab) const {
        const int l = lane_id();
        LAS float* T1 = (LAS float*)(tab + 6144); LAS float* T2 = (LAS float*)(tab + 7168);
#pragma unroll
        for (int k = 0; k < 4; ++k) { const int r = k * 64 + l; const size_t row = (size_t)u.pm * BM + r;
            const float ra = 1.0f / sqrtf(ssa[row] * (1.0f / 1024.0f) + EPS), rr = 1.0f / sqrtf(ssr[row] * (1.0f / 1024.0f) + EPS);
            T1[r] = ra / rr; T2[r] = rr; }
        asm volatile("s_waitcnt lgkmcnt(0)" ::: "memory");
    }
    __device__ __forceinline__ void mid(f32x4 (&acc)[2][2][4][2], int wr, LAS unsigned char* tab) const {
        const LAS float* T1 = (const LAS float*)(tab + 6144); const int fr = lane_id() & 15;
#pragma unroll
        for (int ai = 0; ai < 2; ++ai)
#pragma unroll
            for (int m = 0; m < 4; ++m) { const float s = T1[ai * HALF + wr * 64 + m * 16 + fr];
#pragma unroll
                for (int bj = 0; bj < 2; ++bj)
#pragma unroll
                    for (int n = 0; n < 2; ++n) acc[ai][bj][m][n] *= s; }
        asm volatile("s_waitcnt lgkmcnt(0)" ::: "memory");
    }
    __device__ __forceinline__ void fused(f32x4 (&acc)[2][2][4][2], const Unit& u, int wr, int wc, int fr_, int fq_, LAS unsigned char* tab, int wid, int lane_) const {
        const int lane = lane_id(), fr = lane & 15, fq = lane >> 4;
        const LAS float* St = (const LAS float*)(tab + 4096);
        const int rl0 = wr * 64 + fr, b = u.pm >> 3, col0 = u.pn * BM + wc * 32 + 8 * fq;
        const unsigned eoff0 = (unsigned)(u.pm * BM + rl0) * DM + col0;
        const char* xb = (const char*)x1h;
        half8 xp[2][4][2];
#pragma unroll
        for (int ai = 0; ai < 2; ++ai)
#pragma unroll
            for (int m = 0; m < 4; ++m)
#pragma unroll
                for (int bj = 0; bj < 2; ++bj) xp[ai][m][bj] = *(const half8*)(xb + (size_t)((eoff0 + (unsigned)((ai * HALF + m * 16) * DM + bj * HALF)) * 2u));
        x1.run(acc, u, wr, wc, fr, fq, tab, wid, lane);
        float rs[2][4];
        { const LAS float* T2 = (const LAS float*)(tab + 7168);
#pragma unroll
          for (int ai = 0; ai < 2; ++ai)
#pragma unroll
            for (int m = 0; m < 4; ++m) { const float t2 = T2[rl0 + ai * HALF + m * 16]; rs[ai][m] = t2 / sqrtf(t2 * t2 * St[rl0 + ai * HALF + m * 16] * (1.0f / DM) + EPS); } }
#pragma unroll
        for (int bj = 0; bj < 2; ++bj) { const int c = col0 + bj * HALF;
            const f32x4 a0 = *(const f32x4*)(par + (size_t)(0 * 8 + b) * DM + c), a1 = *(const f32x4*)(par + (size_t)(0 * 8 + b) * DM + c + 4);
#pragma unroll
            for (int ai = 0; ai < 2; ++ai)
#pragma unroll
                for (int m = 0; m < 4; ++m) { const half8 xh = xp[ai][m][bj];
                    const f32x4 x0 = {(float)xh[0], (float)xh[1], (float)xh[2], (float)xh[3]}, x1v = {(float)xh[4], (float)xh[5], (float)xh[6], (float)xh[7]};
                    acc[ai][bj][m][0] = x0 + a0 * (acc[ai][bj][m][0] * rs[ai][m]); acc[ai][bj][m][1] = x1v + a1 * (acc[ai][bj][m][1] * rs[ai][m]); } }
        x2.run(acc, u, wr, wc, fr, fq, tab, wid, lane);
        unsigned eoffS = eoff0; asm volatile("" : "+v"(eoffS));
#pragma unroll
        for (int ai = 0; ai < 2; ++ai)
#pragma unroll
            for (int m = 0; m < 4; ++m) rs[ai][m] = 1.0f / sqrtf(St[rl0 + ai * HALF + m * 16] * (1.0f / DM) + EPS);
#pragma unroll
        for (int bj = 0; bj < 2; ++bj) { const int c = col0 + bj * HALF;
            const f32x4 g0 = *(const f32x4*)(par + (size_t)(1 * 8 + b) * DM + c), g1 = *(const f32x4*)(par + (size_t)(1 * 8 + b) * DM + c + 4);
            const f32x4 s0 = *(const f32x4*)(par + (size_t)(2 * 8 + b) * DM + c), s1 = *(const f32x4*)(par + (size_t)(2 * 8 + b) * DM + c + 4);
#pragma unroll
            for (int ai = 0; ai < 2; ++ai)
#pragma unroll
                for (int m = 0; m < 4; ++m) { const unsigned boff = (eoffS + (unsigned)((ai * HALF + m * 16) * DM + bj * HALF)) * 2u;
                    const f32x4 v0 = acc[ai][bj][m][0], v1 = acc[ai][bj][m][1];
                    u32x4 w; w.x = pk2h(v0[0], v0[1]); w.y = pk2h(v0[2], v0[3]); w.z = pk2h(v1[0], v1[1]); w.w = pk2h(v1[2], v1[3]);
                    *(u32x4*)((char*)x1h + (size_t)boff) = w;
                    const f32x4 h0 = v0 * rs[ai][m] * g0 + s0, h1 = v1 * rs[ai][m] * g1 + s1;
                    u32x4 q; q.x = pk2x<FFN_DT>(h0[0], h0[1]); q.y = pk2x<FFN_DT>(h0[2], h0[3]); q.z = pk2x<FFN_DT>(h1[0], h1[1]); q.w = pk2x<FFN_DT>(h1[2], h1[3]);
                    *(u32x4*)((char*)h2 + (size_t)boff) = q; } }
    }
};
struct EpiFinal {
    static constexpr bool PERM = true, FUSED = true;
    const half_t* x1h; const float* par; float* out; PanelXchg xs;
    __device__ __forceinline__ void fused(f32x4 (&acc)[2][2][4][2], const Unit& u, int wr, int wc, int fr_, int fq_, LAS unsigned char* tab, int wid, int lane_) const {
        const int lane = lane_id(), fr = lane & 15, fq = lane >> 4;
        const LAS float* St = (const LAS float*)(tab + 4096);
        const int rl0 = wr * 64 + fr, b = u.pm >> 3, col0 = u.pn * BM + wc * 32 + 8 * fq;
        const unsigned eoff0 = (unsigned)(u.pm * BM + rl0) * DM + col0;
        const char* xb = (const char*)x1h;
        half8 xp[2][4][2];
#pragma unroll
        for (int ai = 0; ai < 2; ++ai)
#pragma unroll
            for (int m = 0; m < 4; ++m)
#pragma unroll
                for (int bj = 0; bj < 2; ++bj) xp[ai][m][bj] = *(const half8*)(xb + (size_t)((eoff0 + (unsigned)((ai * HALF + m * 16) * DM + bj * HALF)) * 2u));
        xs.run(acc, u, wr, wc, fr, fq, tab, wid, lane);
        unsigned eoffS = eoff0; asm volatile("" : "+v"(eoffS));
        float rs[2][4];
#pragma unroll
        for (int ai = 0; ai < 2; ++ai)
#pragma unroll
            for (int m = 0; m < 4; ++m) rs[ai][m] = 1.0f / sqrtf(St[rl0 + ai * HALF + m * 16] * (1.0f / DM) + EPS);
#pragma unroll
        for (int bj = 0; bj < 2; ++bj) { const int c = col0 + bj * HALF;
            const f32x4 a0 = *(const f32x4*)(par + (size_t)(3 * 8 + b) * DM + c), a1 = *(const f32x4*)(par + (size_t)(3 * 8 + b) * DM + c + 4);
#pragma unroll
            for (int ai = 0; ai < 2; ++ai)
#pragma unroll
                for (int m = 0; m < 4; ++m) { const unsigned boff = (eoffS + (unsigned)((ai * HALF + m * 16) * DM + bj * HALF)) * 4u; const half8 xh = xp[ai][m][bj];
                    const f32x4 x0 = {(float)xh[0], (float)xh[1], (float)xh[2], (float)xh[3]}, x1v = {(float)xh[4], (float)xh[5], (float)xh[6], (float)xh[7]};
                    *(f32x4*)((char*)out + (size_t)boff) = x0 + a0 * (acc[ai][bj][m][0] * rs[ai][m]); *(f32x4*)((char*)out + (size_t)boff + 16) = x1v + a1 * (acc[ai][bj][m][1] * rs[ai][m]); } }
    }
};

struct ProjOrder : StaticOrder {
    unsigned* cnt;
    int wv;
    __device__ __forceinline__ void done(int ui) const {
        if (ui == 3) { asm volatile("s_waitcnt vmcnt(0)" ::: "memory");
            __builtin_amdgcn_s_barrier();
            if (wv == 0 && lane_id() == 0) { __builtin_amdgcn_fence(__ATOMIC_RELEASE, "agent"); asm volatile("s_waitcnt vmcnt(0)" ::: "memory");
                __hip_atomic_fetch_add(cnt + 64 * (c & 7), 1u, __ATOMIC_RELAXED, __HIP_MEMORY_SCOPE_AGENT); } }
    }
};
template <class S> struct has_done { template <class T> static constexpr bool test(decltype(&T::done)) { return true; } template <class T> static constexpr bool test(...) { return false; } static constexpr bool value = test<S>(nullptr); };
struct ListOrder {
    int first, n, pm0, npn;
    __device__ bool next(int i, Unit& u) const { if (i >= n) return false; const int idx = first + i; u.pm = pm0 + idx / npn; u.pn = idx % npn; return true; }
};
template <class E> struct has_mid { template <class T> static constexpr bool test(decltype(T::HAS_MID)*) { return true; } template <class T> static constexpr bool test(...) { return false; } static constexpr bool value = test<E>(nullptr); };
template <class E> struct is_fused { template <class T> static constexpr bool test(decltype(T::FUSED)*) { return true; } template <class T> static constexpr bool test(...) { return false; } static constexpr bool value = test<E>(nullptr); };

template <class Geo, class Epi, class Sched, bool ALIGN_EPI, bool SP2, int DT = 0>
__device__ __forceinline__ void gemm_phase(LAS unsigned char* lds, const Geo g, const Sched& S, const Epi& E, int wv) {
    const int tid = make_tid(wv), wid = __builtin_amdgcn_readfirstlane(tid >> 6), lane = tid & 63, wr = wid >> 2, wc = wid & 3, fr = lane & 15, fq = lane >> 4;
    const int nt = g.nt(); const int ldb = g.ldb();
    unsigned voffA, voffB;
    { int R, C; stage_rc(tid * 16, R, C); const int Rb = Epi::PERM ? ((R & ~31) + perm32(R & 31)) : R; voffA = g.voffA(R, C); voffB = (unsigned)(Rb * ldb + C) * 2u; }
    const size_t dA64 = (size_t)(g.voffA(64, 0) - g.voffA(0, 0)), dB64 = (size_t)64 * ldb * 2;
    const size_t kstepA = g.kstepA(), kstepB = (size_t)(BK * 2);
    const size_t hstepA = g.hstepA(), hstepB = (size_t)HALF * ldb * 2;
    const unsigned ldsw = (unsigned)wid * 1024u;
    const int aoff = lds_byte(wr * 64 + fr, fq * 8), boff = lds_byte(wc * 32 + fr, fq * 8);
#define PG8_SA(b, h) (((b) * 2 + (h)) * HTB)
#define PG8_SB(b, h) ((4 + (b) * 2 + (h)) * HTB)
#define PG8_STAGE(bufoff, gbase, voff) do { \
        __builtin_amdgcn_global_load_lds((const unsigned*)((const char*)(gbase) + (voff)), (LAS unsigned*)(lds + (bufoff) + ldsw), 16, 0, 0); \
        __builtin_amdgcn_global_load_lds((const unsigned*)((const char*)(gbase) + d64_##voff + (voff)), (LAS unsigned*)(lds + (bufoff) + ldsw + 8192), 16, 0, 0); } while (0)
    const size_t d64_voffA = dA64, d64_voffB = dB64;
#define PG8_LDA(dst, b, h) do { _Pragma("unroll") for (int m = 0; m < 4; ++m) _Pragma("unroll") for (int k = 0; k < 2; ++k) dst[m][k] = *(const LAS half8*)(lds + PG8_SA(b, h) + aoff + m * 2048 + k * 1024); } while (0)
#define PG8_LDB(dst, b, h) do { _Pragma("unroll") for (int n = 0; n < 2; ++n) _Pragma("unroll") for (int k = 0; k < 2; ++k) dst[n][k] = *(const LAS half8*)(lds + PG8_SB(b, h) + boff + n * 2048 + k * 1024); } while (0)
#define PG8_MMA(ai, bj, At, Bt) do { __builtin_amdgcn_s_setprio(1); _Pragma("unroll") for (int m = 0; m < 4; ++m) _Pragma("unroll") for (int n = 0; n < 2; ++n) _Pragma("unroll") for (int k = 0; k < 2; ++k) \
        acc[ai][bj][m][n] = DT ? __builtin_amdgcn_mfma_f32_16x16x32_bf16(__builtin_bit_cast(bf16x8, Bt[n][k]), __builtin_bit_cast(bf16x8, At[m][k]), acc[ai][bj][m][n], 0, 0, 0) \
                               : __builtin_amdgcn_mfma_f32_16x16x32_f16(Bt[n][k], At[m][k], acc[ai][bj][m][n], 0, 0, 0); __builtin_amdgcn_s_setprio(0); } while (0)
#define PG8_WAIT_V(n) asm volatile("s_waitcnt vmcnt(" #n ")" ::: "memory")
#define PG8_WAIT_L(n) asm volatile("s_waitcnt lgkmcnt(" #n ")" ::: "memory")
#define PG8_BAR __builtin_amdgcn_s_barrier()
#define PG8_SCHED __builtin_amdgcn_sched_barrier(0)
    Unit cur, nxt; int ui = 0;
    if (!S.next(0, cur)) return;
    f32x4 acc[2][2][4][2];
#pragma unroll
    for (int a = 0; a < 2; ++a)
#pragma unroll
        for (int b = 0; b < 2; ++b)
#pragma unroll
            for (int m = 0; m < 4; ++m)
#pragma unroll
                for (int n = 0; n < 2; ++n) acc[a][b][m][n] = (f32x4){0.f, 0.f, 0.f, 0.f};
    half8 At[4][2], B0[2][2], B1[2][2];
    const char* cA = g.a_base(cur); const char* cB = g.b_base(cur);
    if constexpr (has_mid<Epi>::value) E.unit_begin(cur, lds + XTAB_OFF);
    if constexpr (SP2) {
        PG8_STAGE(PG8_SB(0, 0), cB, voffB); PG8_STAGE(PG8_SB(0, 1), cB + hstepB, voffB); PG8_STAGE(PG8_SA(0, 0), cA, voffA); PG8_STAGE(PG8_SA(0, 1), cA + hstepA, voffA);
        if (wr == 1) PG8_BAR;
        PG8_WAIT_V(2); PG8_BAR;
        PG8_STAGE(PG8_SB(1, 0), cB + kstepB, voffB); PG8_STAGE(PG8_SA(1, 0), cA + kstepA, voffA); PG8_STAGE(PG8_SB(1, 1), cB + hstepB + kstepB, voffB);
        PG8_WAIT_V(6); PG8_BAR;
    } else {
        PG8_STAGE(PG8_SB(0, 0), cB, voffB); PG8_STAGE(PG8_SA(0, 0), cA, voffA); PG8_STAGE(PG8_SB(0, 1), cB + hstepB, voffB); PG8_STAGE(PG8_SA(0, 1), cA + hstepA, voffA);
        if (wr == 1) PG8_BAR;
        PG8_WAIT_V(4); PG8_BAR;
        PG8_STAGE(PG8_SB(1, 0), cB + kstepB, voffB); PG8_STAGE(PG8_SA(1, 0), cA + kstepA, voffA); PG8_STAGE(PG8_SB(1, 1), cB + hstepB + kstepB, voffB);
        PG8_WAIT_V(6); PG8_BAR;
    }
    for (;;) {
        const bool has_next = S.next(ui + 1, nxt);
        const char* nA = has_next ? g.a_base(nxt) : cA; const char* nB = has_next ? g.b_base(nxt) : cB;
        for (int t = 0; t < nt; t += 2) {
            if constexpr (has_mid<Epi>::value) { if (t == nt / 2) E.mid(acc, wr, lds + XTAB_OFF); }
            const bool last = (t == nt - 2);
            const char* a1 = cA + (size_t)(t + 1) * kstepA;
            const char* a2 = last ? nA : cA + (size_t)(t + 2) * kstepA; const char* b2 = last ? nB : cB + (size_t)(t + 2) * kstepB;
            const char* a3 = a2 + kstepA; const char* b3 = b2 + kstepB;
            if constexpr (SP2) {
            PG8_LDB(B0, 0, 0); PG8_LDB(B1, 0, 1); PG8_SCHED; PG8_LDA(At, 0, 0); PG8_STAGE(PG8_SA(1, 1), a1 + hstepA, voffA);
            PG8_WAIT_V(8); PG8_WAIT_L(0); PG8_BAR; PG8_MMA(0, 0, At, B0); PG8_MMA(0, 1, At, B1); PG8_BAR; PG8_SCHED;
            PG8_LDA(At, 0, 1); PG8_STAGE(PG8_SB(0, 0), b2, voffB); PG8_STAGE(PG8_SB(0, 1), b2 + hstepB, voffB); PG8_STAGE(PG8_SA(0, 0), a2, voffA);
            PG8_WAIT_V(8); PG8_WAIT_L(0); PG8_BAR; PG8_MMA(1, 0, At, B0); PG8_MMA(1, 1, At, B1); PG8_BAR; PG8_SCHED;
            PG8_LDB(B0, 1, 0); PG8_LDB(B1, 1, 1); PG8_SCHED; PG8_LDA(At, 1, 0); PG8_STAGE(PG8_SA(0, 1), a2 + hstepA, voffA);
            PG8_WAIT_V(8); PG8_WAIT_L(0); PG8_BAR; PG8_MMA(0, 0, At, B0); PG8_MMA(0, 1, At, B1); PG8_BAR; PG8_SCHED;
            PG8_LDA(At, 1, 1); PG8_STAGE(PG8_SB(1, 0), b3, voffB); PG8_STAGE(PG8_SB(1, 1), b3 + hstepB, voffB); PG8_STAGE(PG8_SA(1, 0), a3, voffA);
            PG8_WAIT_V(8); PG8_WAIT_L(0); PG8_BAR; PG8_MMA(1, 0, At, B0); PG8_MMA(1, 1, At, B1); PG8_BAR; PG8_SCHED;
            } else {
            PG8_LDB(B0, 0, 0); PG8_SCHED; PG8_LDA(At, 0, 0); PG8_STAGE(PG8_SA(1, 1), a1 + hstepA, voffA);
            PG8_WAIT_L(8); PG8_BAR; PG8_WAIT_L(0); PG8_MMA(0, 0, At, B0); PG8_BAR; PG8_SCHED;
            PG8_LDB(B1, 0, 1); PG8_STAGE(PG8_SB(0, 0), b2, voffB);
            PG8_BAR; PG8_WAIT_L(0); PG8_MMA(0, 1, At, B1); PG8_BAR;
            PG8_LDA(At, 0, 1); PG8_STAGE(PG8_SA(0, 0), a2, voffA);
            PG8_BAR; PG8_WAIT_L(0); PG8_MMA(1, 0, At, B0); PG8_BAR; PG8_SCHED;
            PG8_STAGE(PG8_SB(0, 1), b2 + hstepB, voffB);
            PG8_WAIT_V(6); PG8_BAR; PG8_MMA(1, 1, At, B1); PG8_BAR;
            PG8_LDB(B0, 1, 0); PG8_SCHED; PG8_LDA(At, 1, 0); PG8_STAGE(PG8_SA(0, 1), a2 + hstepA, voffA);
            PG8_WAIT_L(8); PG8_BAR; PG8_WAIT_L(0); PG8_MMA(0, 0, At, B0); PG8_BAR; PG8_SCHED;
            PG8_LDB(B1, 1, 1); PG8_STAGE(PG8_SB(1, 0), b3, voffB);
            PG8_BAR; PG8_WAIT_L(0); PG8_MMA(0, 1, At, B1); PG8_BAR;
            PG8_LDA(At, 1, 1); PG8_STAGE(PG8_SA(1, 0), a3, voffA);
            PG8_BAR; PG8_WAIT_L(0); PG8_MMA(1, 0, At, B0); PG8_BAR; PG8_SCHED;
            PG8_STAGE(PG8_SB(1, 1), b3 + hstepB, voffB);
            PG8_WAIT_V(6); PG8_BAR; PG8_MMA(1, 1, At, B1); PG8_BAR;
            }
        }
        if constexpr (ALIGN_EPI) { if (wr == 0) PG8_BAR; }
        if constexpr (is_fused<Epi>::value) E.fused(acc, cur, wr, wc, fr, fq, lds + XTAB_OFF, wid, lane); else E(acc, cur, wr, wc, fr, fq);
        if constexpr (has_done<Sched>::value) S.done(ui);
        if (!has_next) break;
        if constexpr (has_mid<Epi>::value) E.unit_begin(nxt, lds + XTAB_OFF);
#pragma unroll
        for (int a = 0; a < 2; ++a)
#pragma unroll
            for (int b = 0; b < 2; ++b)
#pragma unroll
                for (int m = 0; m < 4; ++m)
#pragma unroll
                    for (int n = 0; n < 2; ++n) acc[a][b][m][n] = (f32x4){0.f, 0.f, 0.f, 0.f};
        cur = nxt; cA = nA; cB = nB; ++ui;
        if constexpr (ALIGN_EPI) { if (wr == 1) PG8_BAR; }
    }
    PG8_WAIT_V(0);
    if constexpr (!ALIGN_EPI) { if (wr == 0) PG8_BAR; }
    PG8_BAR;
#undef PG8_SA
#undef PG8_SB
#undef PG8_STAGE
#undef PG8_LDA
#undef PG8_LDB
#undef PG8_MMA
#undef PG8_WAIT_V
#undef PG8_WAIT_L
#undef PG8_BAR
#undef PG8_SCHED
}
}

#define XB_TMO      128
#define XB_XCNT(j)  (256  + 64 * (j))
#define XB_XSUB(j)  (1280 + 64 * (j))
#define XB_XGEN(j)  (2304 + 64 * (j))
#define XB_TOP      3328
#define XB_TOPGEN   3392
#define XCD_BAR_WORDS 3456
#define XB_SPIN_CAP (1u << 22)
__device__ __forceinline__ unsigned xb_ld(unsigned* p)              { return __hip_atomic_load(p, __ATOMIC_RELAXED, __HIP_MEMORY_SCOPE_AGENT); }
__device__ __forceinline__ unsigned xb_add(unsigned* p, unsigned v) { return __hip_atomic_fetch_add(p, v, __ATOMIC_RELAXED, __HIP_MEMORY_SCOPE_AGENT); }
__device__ __forceinline__ unsigned xb_xcc_id() { return (unsigned)__builtin_amdgcn_s_getreg((3 << 11) | 20) & 0xFu; }
#define XB_SPIN(cond, bar) do { unsigned _sp = 0; while (cond) { __builtin_amdgcn_s_sleep(1); \
    if ((++_sp & 255u) == 0u) { if (xb_ld(&(bar)[XB_TMO])) break; if (_sp > XB_SPIN_CAP) { atomicAdd(&(bar)[XB_TMO], 1u); break; } } } } while (0)
struct XcdBarrier { unsigned* bar; unsigned x; volatile LAS unsigned* st; int wv; };
__device__ __forceinline__ XcdBarrier xcd_barrier_post(unsigned* bar, volatile LAS unsigned* st, int wv) {
    XcdBarrier b; b.bar = bar; b.x = xb_xcc_id(); b.st = st; b.wv = wv;
    if (wv == 0 && lane_id() == 0) (void)xb_add(&bar[XB_XCNT(b.x)], 1u);
    return b;
}
__device__ __forceinline__ void xcd_barrier_complete(unsigned* bar, unsigned x, unsigned& nloc, unsigned& nx) {
    const unsigned G = gridDim.x * gridDim.y * gridDim.z;
    unsigned sum, cnt, mine, sp = 0u;
    for (;;) {
        sum = 0u; cnt = 0u; mine = 0u;
#pragma unroll
        for (unsigned j = 0; j < 16; ++j) { const unsigned c = xb_ld(&bar[XB_XCNT(j)]); sum += c; cnt += (c > 0u) ? 1u : 0u; mine = (j == x) ? c : mine; }
        if (sum == G) break;
        __builtin_amdgcn_s_sleep(1);
        if ((++sp & 255u) == 0u) { if (xb_ld(&bar[XB_TMO])) break; if (sp > XB_SPIN_CAP) { atomicAdd(&bar[XB_TMO], 1u); break; } }
    }
    nloc = mine > 0u ? mine : 1u; nx = cnt > 0u ? cnt : 1u;
}
__device__ __forceinline__ void xcd_barrier(const XcdBarrier& b) {
    asm volatile("s_waitcnt vmcnt(0)" ::: "memory");
    __syncthreads();
    if (b.wv == 0 && lane_id() == 0) {
        unsigned* bar = b.bar;
        __builtin_amdgcn_s_waitcnt(0);
        unsigned nloc = b.st[0], nx = b.st[1];
        if (nloc == 0u) { xcd_barrier_complete(bar, b.x, nloc, nx); b.st[0] = nloc; b.st[1] = nx; }
        const unsigned old = xb_add(&bar[XB_XSUB(b.x)], 1u);
        const unsigned gen = old / nloc;
        if (old + 1u == (gen + 1u) * nloc) {
            __builtin_amdgcn_fence(__ATOMIC_RELEASE, "agent");
            asm volatile("s_waitcnt vmcnt(0)" ::: "memory");
            const unsigned og = xb_add(&bar[XB_TOP], 1u);
            const unsigned tg = og / nx;
            if (og + 1u == (tg + 1u) * nx) xb_add(&bar[XB_TOPGEN], 1u);
            else XB_SPIN(xb_ld(&bar[XB_TOPGEN]) == tg, bar);
            __builtin_amdgcn_fence(__ATOMIC_ACQUIRE, "agent");
            xb_add(&bar[XB_XGEN(b.x)], 1u);
            asm volatile("s_waitcnt vmcnt(0)" ::: "memory");
        } else {
            XB_SPIN(xb_ld(&bar[XB_XGEN(b.x)]) == gen, bar);
            __builtin_amdgcn_fence(__ATOMIC_ACQUIRE, "agent");
            asm volatile("s_waitcnt vmcnt(0)" ::: "memory");
        }
    }
    __syncthreads();
}

constexpr int NWAVES = 8;
constexpr int RING_BYTES = 131072;
constexpr int LDSCTL_OFF = RING_BYTES, MISC_OFF = LDSCTL_OFF + 320;
constexpr int LDS_BYTES = 147456;

struct Args { const float* in[27]; float* out; unsigned char* ws; int ph_lo, ph_hi; };
typedef const __attribute__((address_space(4))) Args* ArgsP;
__device__ __forceinline__ ArgsP get_args() { ArgsP p = (ArgsP)__builtin_amdgcn_kernarg_segment_ptr(); asm volatile("" : "+s"(p)); return p; }

enum { I_X = 0, I_C, I_WADA, I_BADA, I_GPREMIX, I_GPOSTMIX, I_GPREMLP, I_GPOSTMLP, I_WIN, I_C1K, I_C2K, I_PEK, I_C1V, I_C2V, I_PEV,
       I_CONVW, I_CONVB, I_WRGA, I_BRGA, I_WRGX, I_BRGX, I_LAM, I_GATT, I_GRNN, I_WOUT, I_WFF1, I_WFF2 };

struct Frame {
    LAS unsigned char* lds;
    unsigned char* ws;
    int vcu, G, wv;
};
struct Ids { int tid, lane, wave; };
__device__ __forceinline__ Ids get_ids(int wv) { Ids r; r.tid = make_tid(wv); r.lane = r.tid & 63; r.wave = wv; return r; }

typedef short v4i16_t __attribute__((ext_vector_type(4)));
template <int DT = 0, int PMODE = 0>
__device__ __forceinline__ void transpose_item(const float* W, int ldw, int k0, int srccol, half_t* dst  , int ldk, LAS unsigned char* scr, int lane) {
    const int g = lane >> 4, p = lane & 15;
    f32x4 v[16];
#pragma unroll
    for (int i = 0; i < 16; ++i) v[i] = (srccol >= 0 && PMODE != 2) ? *(const f32x4*)(W + (size_t)(k0 + 16 * g + i) * ldw + srccol) : (f32x4){0.f, 0.f, 0.f, 0.f};
#pragma unroll
    for (int j = 0; j < 4; ++j) {
        const int n = 4 * p + j;
        LAS unsigned char* wr = scr + n * 128;
#pragma unroll
        for (int h = 0; h < 2; ++h) {
            u32x4 o; o.x = pk2x<DT>(v[8 * h + 0][j], v[8 * h + 1][j]); o.y = pk2x<DT>(v[8 * h + 2][j], v[8 * h + 3][j]); o.z = pk2x<DT>(v[8 * h + 4][j], v[8 * h + 5][j]); o.w = pk2x<DT>(v[8 * h + 6][j], v[8 * h + 7][j]);
            *(LAS u32x4*)(wr + (((2 * g + h) ^ (p & 7)) * 16)) = o;
        }
    }
    LDS_WAIT(); asm volatile("" ::: "memory");
    const int kc = lane & 7;
#pragma unroll
    for (int jj = 0; jj < 8; ++jj) {
        const int n = 8 * jj + (lane >> 3);
        const u32x4 o = *(const LAS u32x4*)(scr + n * 128 + ((kc ^ ((n >> 2) & 7)) * 16));
        if (PMODE != 3) *(u32x4*)(dst + (size_t)n * ldk + 8 * kc) = o; else asm volatile("" :: "v"(o));
    }
    LDS_WAIT(); asm volatile("" ::: "memory");
}

__device__ __forceinline__ void p0_prologue(Frame& F, int rep) {
    ArgsP ap = get_args();
    const Ids I = get_ids(F.wv);
    unsigned char* ws = F.ws;
    __syncthreads();
    {
        LAS float* cact = (LAS float*)F.lds;
        LAS float* part = (LAS float*)(F.lds + 65536);
        const float* c = ap->in[I_C];
        for (int i = I.tid; i < NB * DM; i += 512) cact[(i % DM) * 8 + i / DM] = siluf_(c[i]);
        __syncthreads();
        const float* wada = ap->in[I_WADA]; float* mod = (float*)(ws + WS_MOD);
        for (int cv = F.vcu; cv < 256; cv += F.G) {
        const int col0 = 48 * cv, cq = I.tid % 12, ro = I.tid / 12;
        if (ro < 42) {
            f32x4 acc[8];
#pragma unroll
            for (int b = 0; b < 8; ++b) acc[b] = (f32x4){0.f, 0.f, 0.f, 0.f};
            const float* wp = wada + (size_t)ro * 12288 + col0 + 4 * cq;
            f32x4 w4[2][8];
#pragma unroll
            for (int u = 0; u < 8; ++u) w4[0][u] = *(const f32x4*)(wp + (size_t)u * 42 * 12288);
            __builtin_amdgcn_sched_barrier(0);
#pragma unroll
            for (int jq = 0; jq < 6; ++jq) { const int jb = 8 * jq;
                if (jq + 1 < 6) {
#pragma unroll
                    for (int u = 0; u < 8; ++u) w4[(jq + 1) & 1][u] = *(const f32x4*)(wp + (size_t)(jb + 8 + u) * 42 * 12288); }
                __builtin_amdgcn_sched_barrier(0);
#pragma unroll
                for (int u = 0; u < 8; ++u) { const int k = ro + 42 * (jb + u); const f32x4 c0 = *(const LAS f32x4*)(cact + k * 8), c1 = *(const LAS f32x4*)(cact + k * 8 + 4); const f32x4 wv = w4[jq & 1][u];
                    acc[0] += wv * c0.x; acc[1] += wv * c0.y; acc[2] += wv * c0.z; acc[3] += wv * c0.w; acc[4] += wv * c1.x; acc[5] += wv * c1.y; acc[6] += wv * c1.z; acc[7] += wv * c1.w; }
                __builtin_amdgcn_sched_barrier(0);
            }
            { const int k = ro + 42 * 48; if (k < DM) { const f32x4 w4 = *(const f32x4*)(wp + (size_t)48 * 42 * 12288);
#pragma unroll
                for (int b = 0; b < 8; ++b) acc[b] += w4 * cact[k * 8 + b]; } }
#pragma unroll
            for (int b = 0; b < 8; ++b) *(LAS f32x4*)(part + (ro * 8 + b) * 48 + 4 * cq) = acc[b];
        }
        __syncthreads();
        if (I.tid < 384) { const int b = I.tid / 48, cc = I.tid % 48; float s = ap->in[I_BADA][col0 + cc];
            for (int r = 0; r < 42; ++r) s += part[(r * 8 + b) * 48 + cc];
            mod[b * 12288 + col0 + cc] = s; }
        __syncthreads();
        }
    }
    if (rep == 0) for (int bv = F.vcu; bv < 32; bv += F.G) {
        const int m = bv >> 4, ks = bv & 15, col = I.tid & 255, hf = I.tid >> 8;
        const float* pe = ap->in[m ? I_PEV : I_PEK]; const float* w1 = ap->in[m ? I_C1V : I_C1K];
        float acc = 0.f; const int kb = 128 * ks + 64 * hf;
#pragma unroll 16
        for (int k = kb; k < kb + 64; ++k) acc += pe[k] * w1[(size_t)k * 256 + col];
        atomicAdd((float*)(ws + WS_CTL) + CW_BIAS1 + m * 256 + col, acc);
    }
    if (F.vcu == 32 || F.G <= 32) { for (int i = I.tid; i < 1024; i += 512) ((float*)(ws + WS_SP8))[i] = 8.0f * log1pf(expf(-ap->in[I_LAM][i])); }
    LAS unsigned char* scr = F.lds + I.wave * 16384;
    const int gw = F.vcu * NWAVES + I.wave, NGW = F.G * NWAVES;
    constexpr int IT_IN = 32 * (NP / 64), IT_OUT = 32 * 32, IT_FF1 = 32 * 128, IT_FF2 = 128 * 32, IT_C1 = 32 * 4, IT_RG = 8 * 2 * 4;
    constexpr int NITEMS = IT_IN + IT_OUT + IT_FF1 + IT_FF2 + 2 * IT_C1 + IT_RG;
    half_t* Wt_in = (half_t*)(ws + WS_WIN); half_t* Wt_out = (half_t*)(ws + WS_WOUT); half_t* Wt_ff1 = (half_t*)(ws + WS_WFF1); half_t* Wt_ff2 = (half_t*)(ws + WS_WFF2);
    half_t* Wt_c1 = (half_t*)(ws + WS_WC1); half_t* Wt_rg = (half_t*)(ws + WS_WRG);
    const int l4 = 4 * (I.lane & 15);
#if PROBE_TM == 1
#define TM_MAP(r, nblk) const int gi_ = (r) >> 3, sub_ = (r) & 7, kb = (gi_ / ((nblk) / 2)) * 4 + (sub_ >> 1), nb = (gi_ % ((nblk) / 2)) * 2 + (sub_ & 1)
#elif PROBE_TM == 2
#define TM_MAP(r, nblk) const int gi_ = (r) >> 3, sub_ = (r) & 7, kb = (gi_ / (nblk)) * 8 + sub_, nb = gi_ % (nblk)
#else
#define TM_MAP(r, nblk) const int kb = (r) / (nblk), nb = (r) % (nblk)
#endif
    static_assert(NITEMS % 8 == 0, "items split evenly over the 8 XCD queues");
    const int xq = F.vcu >> 5;
    unsigned* icnt = (unsigned*)(ws + WS_CTL) + CW_P0Q + 64 * xq;
    const bool dyn = (F.G == 256);
    for (int it = dyn ? 8 * ((F.vcu & 31) * NWAVES + I.wave) + xq : gw; it < NITEMS; ) {
        unsigned got = 0u; if (dyn && I.lane == 0) got = __hip_atomic_fetch_add(icnt, 1u, __ATOMIC_RELAXED, __HIP_MEMORY_SCOPE_AGENT);
        int r = it;
        if (r < IT_IN) { const int nblk = NP / 64; TM_MAP(r, nblk); const int n = nb * 64 + l4;
            const int sc = n < 2560 ? n : (n < 4608 ? n + 48 : (n < 4656 ? n - 2048 : -1));
            transpose_item<PROJ_DT>(ap->in[I_WIN], NPROJ, 64 * kb, sc, Wt_in + (size_t)(nb * 64) * DM + 64 * kb, DM, scr, I.lane); goto item_done; } r -= IT_IN;
        if (r < IT_OUT) { const int nblk = 32; TM_MAP(r, nblk);
            transpose_item<FFN_DT>(ap->in[I_WOUT], DM, 64 * kb, nb * 64 + l4, Wt_out + (size_t)(nb * 64) * DM + 64 * kb, DM, scr, I.lane); goto item_done; } r -= IT_OUT;
        if (r < IT_FF1) { const int nblk = 128; TM_MAP(r, nblk);
            transpose_item<FFN_DT>(ap->in[I_WFF1], DFF, 64 * kb, nb * 64 + l4, Wt_ff1 + (size_t)(nb * 64) * DM + 64 * kb, DM, scr, I.lane); goto item_done; } r -= IT_FF1;
        if (r < IT_FF2) { const int nblk = 32; TM_MAP(r, nblk);
            transpose_item<FFN_DT>(ap->in[I_WFF2], DM, 64 * kb, nb * 64 + l4, Wt_ff2 + (size_t)(nb * 64) * DFF + 64 * kb, DFF, scr, I.lane); goto item_done; } r -= IT_FF2;
        if (r < 2 * IT_C1) { const int m = r / IT_C1, q = r % IT_C1, nblk = 4; TM_MAP(q, nblk);
            transpose_item(ap->in[m ? I_C1V : I_C1K], 256, 64 * kb, nb * 64 + l4, Wt_c1 + (size_t)(m * 256 + nb * 64) * 2048 + 64 * kb, 2048, scr, I.lane); goto item_done; } r -= 2 * IT_C1;
        {
            const int q = r & 3, gate = (r >> 2) & 1, blk = r >> 3, kb = q >> 1, nb = q & 1;
            const float* W = ap->in[gate ? I_WRGX : I_WRGA] + (size_t)blk * 128 * 128;
            half_t* rowbase = Wt_rg + (size_t)(blk * 256 + gate * 128 + nb * 64) * 128;
            transpose_item(W, 128, 64 * kb, nb * 64 + l4, rowbase + 64 * kb, 128, scr, I.lane);
        }
item_done:
        it = dyn ? 8 * (256 + (int)__builtin_amdgcn_readfirstlane((int)got)) + xq : it + NGW;
    }
#if PROBE_P0X
    for (int it = gw; it < IT_FF1; it += NGW) { const int r = it; const int nblk = 128; TM_MAP(r, nblk);
        transpose_item<FFN_DT, PROBE_P0X - 1>(ap->in[I_WFF1], DFF, 64 * kb, nb * 64 + l4, (half_t*)(ws + WS_H2) + (size_t)(nb * 64) * DM + 64 * kb, DM, scr, I.lane); }
#endif
}

__device__ __forceinline__ void p1_norm(Frame& F) {
    ArgsP ap = get_args();
    const Ids I = get_ids(F.wv);
    const int gw = F.vcu * NWAVES + I.wave, NGW = F.G * NWAVES;
    const float* mod = (const float*)(F.ws + WS_MOD); half_t* hbuf = (half_t*)(F.ws + WS_HBUF); half_t* xh = (half_t*)(F.ws + WS_X1H);
    {
        float* par = (float*)(F.ws + WS_PAR);
        for (int i = F.vcu * 512 + I.tid; i < NB * DM; i += F.G * 512) { const int b = i / DM, c = i % DM; const float* mb = mod + b * 12288;
            par[(0 * 8 + b) * DM + c] = mb[4096 + c] * ap->in[I_GPOSTMIX][c];
            par[(1 * 8 + b) * DM + c] = ap->in[I_GPREMLP][c] * (1.0f + mb[8192 + c]);
            par[(2 * 8 + b) * DM + c] = mb[6144 + c];
            par[(3 * 8 + b) * DM + c] = mb[10240 + c] * ap->in[I_GPOSTMLP][c]; }
    }
    const bool dyn = (F.G == 256); const int xq = F.vcu >> 5;
    unsigned* rcnt = (unsigned*)(F.ws + WS_CTL) + CW_P1Q + 64 * xq;
    constexpr int RB = 4, NRB = NTOK / RB;
    for (int rb = dyn ? 8 * ((F.vcu & 31) * NWAVES + I.wave) + xq : gw; rb < NRB; ) {
        unsigned got = 0u; if (dyn && I.lane == 0) got = __hip_atomic_fetch_add(rcnt, 1u, __ATOMIC_RELAXED, __HIP_MEMORY_SCOPE_AGENT);
        const int row0 = rb * RB, b = row0 / SEQ;
        f32x4 A[8], Bv[8];
#pragma unroll
        for (int j = 0; j < 8; ++j) { const int c = 4 * I.lane + 256 * j; const f32x4 g = *(const f32x4*)(ap->in[I_GPREMIX] + c), sc = *(const f32x4*)(mod + b * 12288 + 2048 + c); A[j] = g * (sc + 1.0f); Bv[j] = *(const f32x4*)(mod + b * 12288 + c); }
        for (int r = 0; r < RB; ++r) {
            const float* xr = ap->in[I_X] + (size_t)(row0 + r) * DM; f32x4 v[8]; float s = 0.f;
#pragma unroll
            for (int j = 0; j < 8; ++j) { v[j] = *(const f32x4*)(xr + 4 * I.lane + 256 * j); s += (v[j].x * v[j].x + v[j].y * v[j].y) + (v[j].z * v[j].z + v[j].w * v[j].w); }
            const float rstd = 1.0f / sqrtf(wave_sum(s) * (1.0f / DM) + EPS);
            half_t* ho = hbuf + (size_t)(row0 + r) * DM; half_t* xo = xh + (size_t)(row0 + r) * DM;
#pragma unroll
            for (int j = 0; j < 8; ++j) { const f32x4 y = v[j] * rstd * A[j] + Bv[j]; u32x2 w; w.x = pk2x<PROJ_DT>(y.x, y.y); w.y = pk2x<PROJ_DT>(y.z, y.w); *(u32x2*)(ho + 4 * I.lane + 256 * j) = w;
                u32x2 wx; wx.x = pk2h(v[j].x, v[j].y); wx.y = pk2h(v[j].z, v[j].w); *(u32x2*)(xo + 4 * I.lane + 256 * j) = wx; }
        }
        rb = dyn ? 8 * (256 + (int)__builtin_amdgcn_readfirstlane((int)got)) + xq : rb + NGW;
    }
}

__device__ __forceinline__ void p3_conv(Frame& F, int rb_first, int rb_last, int worker, int nworkers) {
    ArgsP ap = get_args();
    const Ids I = get_ids(F.wv);
    const half_t* P = (const half_t*)(F.ws + WS_P); half_t* xc = (half_t*)(F.ws + WS_XC);
    const float* cw = ap->in[I_CONVW]; const float* cb = ap->in[I_CONVB];
    for (int rb = rb_first + worker; rb < rb_last; rb += nworkers) {
#pragma unroll
        for (int hh = 0; hh < 2; ++hh) {
            const int c0 = hh * 512 + 8 * I.lane;
            const int row0 = rb * 8, t0 = row0 % SEQ;
            half8 xin[11];
#pragma unroll
            for (int i = 0; i < 11; ++i) { const int tt = t0 - 3 + i; xin[i] = (tt >= 0) ? *(const half8*)(P + (size_t)(row0 - 3 + i) * NP + PC_XR + c0) : (half8){0, 0, 0, 0, 0, 0, 0, 0}; }
            f32x4 w[4][2], bb[2];
#pragma unroll
            for (int k = 0; k < 4; ++k) { w[k][0] = *(const f32x4*)(cw + k * 1024 + c0); w[k][1] = *(const f32x4*)(cw + k * 1024 + c0 + 4); }
            bb[0] = *(const f32x4*)(cb + c0); bb[1] = *(const f32x4*)(cb + c0 + 4);
#pragma unroll
            for (int r = 0; r < 8; ++r) {
                f32x4 a0 = bb[0], a1 = bb[1];
#pragma unroll
                for (int k = 0; k < 4; ++k) { const half8 xv = xin[r + k];
                    a0 += w[k][0] * (f32x4){(float)xv[0], (float)xv[1], (float)xv[2], (float)xv[3]}; a1 += w[k][1] * (f32x4){(float)xv[4], (float)xv[5], (float)xv[6], (float)xv[7]}; }
                u32x4 o; o.x = pk2h(a0[0], a0[1]); o.y = pk2h(a0[2], a0[3]); o.z = pk2h(a1[0], a1[1]); o.w = pk2h(a1[2], a1[3]);
                *(u32x4*)(xc + (size_t)(row0 + r) * 1024 + c0) = o;
            }
        }
    }
}

__device__ __forceinline__ void p4_cmp2(Frame& F) {
    ArgsP ap = get_args();
    const Ids I = get_ids(F.wv);
    const float* slab = (const float*)(F.ws + WS_SLAB); const float* bias1 = (const float*)(F.ws + WS_CTL) + CW_BIAS1;
    LAS float* W2 = (LAS float*)F.lds;
    LAS float* scr = (LAS float*)(F.lds + 65536 + I.wave * 4096);
    const int NGW = F.G * NWAVES;
    int mload = -1;
    for (int g4 = F.vcu * NWAVES + I.wave; g4 < 2048; g4 += NGW) {
        const int m = g4 >> 10, r0 = (g4 & 1023) * 4;
        const int mwg = (F.vcu * NWAVES) >> 10;
        if (mload != m) {
            __syncthreads();
            const float* w2 = ap->in[m ? I_C2V : I_C2K];
            for (int i = I.tid; i < 256 * 64 / 4; i += 512) *(LAS f32x4*)(W2 + 4 * i) = *(const f32x4*)(w2 + 4 * i);
            __syncthreads(); mload = m; (void)mwg;
        }
#pragma unroll
        for (int q = 0; q < 4; ++q) { const int r = r0 + q;
            f32x4 hv = *(const f32x4*)(bias1 + m * 256 + 4 * I.lane);
#pragma unroll
            for (int s = 0; s < 2; ++s) hv += *(const f32x4*)(slab + ((size_t)s * 4096 + r) * 512 + m * 256 + 4 * I.lane);
            scr[(4 * I.lane + 0) * 4 + q] = gelu_tanh(hv.x); scr[(4 * I.lane + 1) * 4 + q] = gelu_tanh(hv.y); scr[(4 * I.lane + 2) * 4 + q] = gelu_tanh(hv.z); scr[(4 * I.lane + 3) * 4 + q] = gelu_tanh(hv.w); }
        LDS_WAIT(); asm volatile("" ::: "memory");
        f32x4 acc = {0.f, 0.f, 0.f, 0.f};
#pragma unroll 8
        for (int c = 0; c < 256; ++c) { const float w = W2[c * 64 + I.lane]; const f32x4 s4 = *(const LAS f32x4*)(scr + 4 * c); acc += s4 * w; }
        half_t* dst = (half_t*)(F.ws + (m ? WS_VCMP : WS_KCMP)) + (size_t)r0 * 64 + I.lane;
        dst[0] = (half_t)acc.x; dst[64] = (half_t)acc.y; dst[128] = (half_t)acc.z; dst[192] = (half_t)acc.w;
        LDS_WAIT(); asm volatile("" ::: "memory");
    }
}

__device__ __forceinline__ void p5_scan(Frame& F) {
    const Ids I = get_ids(F.wv);
    const unsigned* ab = (const unsigned*)(F.ws + WS_ABUF); const half_t* P = (const half_t*)(F.ws + WS_P);
    unsigned short* amix = (unsigned short*)(F.ws + WS_AMIX); float* ssr = (float*)(F.ws + WS_CTL) + CW_SSR; const float* grnn = get_args()->in[I_GRNN];
    LAS float* sA = (LAS float*)F.lds; LAS float* sB = sA + 2048; LAS float* sC = sB + 2048;
    for (int u = F.vcu; u < 256; u += F.G) {
        const int b = u >> 5, cg = u & 31, cq = I.tid & 7, seg = I.tid >> 3, c0 = cg * 32 + 4 * cq;
        const size_t row0 = (size_t)b * SEQ + seg * 32;
        float Ap[4] = {1.f, 1.f, 1.f, 1.f}, Bp[4] = {0.f, 0.f, 0.f, 0.f};
        half8 wq[32];
        { const unsigned* pw = ab + row0 * 1024 + c0;
#pragma unroll
          for (int t = 0; t < 32; ++t) { wq[t] = *(const half8*)pw; pw += 1024; asm volatile("" : "+v"(pw)); } }
        __builtin_amdgcn_sched_barrier(0);
#pragma unroll
        for (int t = 0; t < 32; ++t) { const half8 w = wq[t];
#pragma unroll
            for (int j = 0; j < 4; ++j) { const float av = 1.0f - (float)w[2 * j], bv = (float)w[2 * j + 1]; Bp[j] = av * Bp[j] + bv; Ap[j] *= av; } }
#pragma unroll
        for (int j = 0; j < 4; ++j) { sA[seg * 32 + 4 * cq + j] = Ap[j]; sB[seg * 32 + 4 * cq + j] = Bp[j]; }
        __syncthreads();
        if (I.tid < 32) { float h = 0.f;
            for (int s = 0; s < 64; ++s) { sC[s * 32 + I.tid] = h; h = sA[s * 32 + I.tid] * h + sB[s * 32 + I.tid]; } }
        __syncthreads();
        float h[4], gc[4];
#pragma unroll
        for (int j = 0; j < 4; ++j) { h[j] = sC[seg * 32 + 4 * cq + j]; gc[j] = grnn[c0 + j]; }
#pragma unroll
        for (int t = 0; t < 32; ++t) asm volatile("" : "+v"(wq[t]));
#pragma unroll
        for (int tb = 0; tb < 32; tb += 16) {
        half4 yq[16];
        { const half_t* py = P + (row0 + tb) * NP + PC_YR + c0;
#pragma unroll
          for (int t = 0; t < 16; ++t) { yq[t] = *(const half4*)py; py += NP; asm volatile("" : "+v"(py)); } }
        __builtin_amdgcn_sched_barrier(0);
#pragma unroll
        for (int tt = 0; tt < 16; ++tt) { const int t = tb + tt; const half8 w = wq[t]; const half4 yv = yq[tt];
            float o[4], q = 0.f;
#pragma unroll
            for (int j = 0; j < 4; ++j) { const float av = 1.0f - (float)w[2 * j], bv = (float)w[2 * j + 1]; h[j] = av * h[j] + bv;
                o[j] = gelu_tanh((float)yv[j]) * h[j]; q += o[j] * o[j]; }
            u32x2 ow; ow.x = pk2x<FFN_DT>(o[0] * gc[0], o[1] * gc[1]); ow.y = pk2x<FFN_DT>(o[2] * gc[2], o[3] * gc[3]);
            *(u32x2*)(amix + (row0 + t) * 2048 + 1024 + c0) = ow;
            q += __shfl_xor(q, 1); q += __shfl_xor(q, 2); q += __shfl_xor(q, 4);
            if (cq == 0) atomicAdd(ssr + row0 + t, q); }
        __builtin_amdgcn_sched_barrier(0);
        }
        __syncthreads();
    }
}

namespace att {
typedef float f32x16 __attribute__((ext_vector_type(16)));
constexpr int L_KB = 0, L_VB = 24576  , L_WSF = 49152, L_IMP = 51200, L_RES = L_IMP  , L_MASK = L_IMP + 69632, L_UM = L_MASK + 256;
constexpr int RS = 68;
constexpr float THR = 8.0f, MFLOOR = -1000.0f, NEGBIG = -1e30f;
__device__ __forceinline__ int crow(int r, int hi) { return (r & 3) + 8 * (r >> 2) + 4 * hi; }
#define ATT_SBAR() __builtin_amdgcn_sched_barrier(0)
__device__ __forceinline__ void qkt(f32x16& p0, f32x16& p1, const LAS unsigned char* Kslot, const half8 (&qr)[4], int r32, int hi) {
    const LAS unsigned char* kb = Kslot + hi * 1024 + r32 * 16;
    f32x16 a = {}, b = {};
#pragma unroll
    for (int d0 = 0; d0 < 4; ++d0) {
        const half8 b0 = *(const LAS half8*)(kb + d0 * 2048);
        const half8 b1 = *(const LAS half8*)(kb + d0 * 2048 + 512);
        a = __builtin_amdgcn_mfma_f32_32x32x16_f16(b0, qr[d0], a, 0, 0, 0);
        b = __builtin_amdgcn_mfma_f32_32x32x16_f16(b1, qr[d0], b, 0, 0, 0);
    }
    p0 = a; p1 = b;
}
__device__ __forceinline__ float rowmax(const f32x16& p0, const f32x16& p1) {
    float a = fmaxf(p0[0], p1[0]);
#pragma unroll
    for (int r = 1; r < 16; ++r) a = fmaxf(a, fmaxf(p0[r], p1[r]));
    auto rr = __builtin_amdgcn_permlane32_swap(__float_as_uint(a), __float_as_uint(a), false, false);
    return fmaxf(__uint_as_float(rr[0]), __uint_as_float(rr[1]));
}
__device__ __forceinline__ void pv(f32x16 (&o)[2], int vb, half8 pa0, half8 pa1, half8 pa2, half8 pa3) {
    half4 lo[2][4], hi[2][4];
#pragma unroll
    for (int d0 = 0; d0 < 2; ++d0)
#pragma unroll
        for (int ks = 0; ks < 4; ++ks) {
            asm volatile("ds_read_b64_tr_b16 %0,%1 offset:%c2" : "=&v"(lo[d0][ks]) : "v"(vb), "i"(d0 * 4096 + ks * 1024) : "memory");
            asm volatile("ds_read_b64_tr_b16 %0,%1 offset:%c2" : "=&v"(hi[d0][ks]) : "v"(vb), "i"(d0 * 4096 + ks * 1024 + 512) : "memory"); }
    asm volatile("s_waitcnt lgkmcnt(0)" ::: "memory"); ATT_SBAR();
#define ATT_PK(d, k) (half8){lo[d][k][0], lo[d][k][1], lo[d][k][2], lo[d][k][3], hi[d][k][0], hi[d][k][1], hi[d][k][2], hi[d][k][3]}
#pragma unroll
    for (int d0 = 0; d0 < 2; ++d0) {
        o[d0] = __builtin_amdgcn_mfma_f32_32x32x16_f16(pa0, ATT_PK(d0, 0), o[d0], 0, 0, 0);
        o[d0] = __builtin_amdgcn_mfma_f32_32x32x16_f16(pa1, ATT_PK(d0, 1), o[d0], 0, 0, 0);
        o[d0] = __builtin_amdgcn_mfma_f32_32x32x16_f16(pa2, ATT_PK(d0, 2), o[d0], 0, 0, 0);
        o[d0] = __builtin_amdgcn_mfma_f32_32x32x16_f16(pa3, ATT_PK(d0, 3), o[d0], 0, 0, 0);
    }
#undef ATT_PK
}
__device__ __forceinline__ half8 pack8(const f32x16& p, int b) {
    u32x4 w; w.x = pk2h(p[b + 0], p[b + 1]); w.y = pk2h(p[b + 2], p[b + 3]); w.z = pk2h(p[b + 4], p[b + 5]); w.w = pk2h(p[b + 6], p[b + 7]);
    return __builtin_bit_cast(half8, w);
}
__device__ __forceinline__ void load_kv(LAS unsigned char* lds, int kslot, int vslot, const unsigned char* kbase, const unsigned char* vbase, size_t pitch, int wid, int lane) {
    const unsigned char* ks = kbase + (size_t)lane * pitch + wid * 16;
    const unsigned char* vs = vbase + (size_t)(16 * (wid & 3) + (lane >> 2)) * pitch + (wid >> 2) * 64 + (lane & 3) * 16;
    __builtin_amdgcn_global_load_lds((const unsigned*)ks, (LAS unsigned*)(lds + kslot + wid * 1024), 16, 0, 0);
    __builtin_amdgcn_global_load_lds((const unsigned*)vs, (LAS unsigned*)(lds + vslot + wid * 1024), 16, 0, 0);
}
#define ATT_RING_SYNC(ahead) do { if ((ahead) >= 1) asm volatile("s_waitcnt vmcnt(2) lgkmcnt(0)" ::: "memory"); else asm volatile("s_waitcnt vmcnt(0) lgkmcnt(0)" ::: "memory"); \
    __builtin_amdgcn_s_barrier(); asm volatile("" ::: "memory"); } while (0)
#define ATT_SYNC() do { asm volatile("s_waitcnt vmcnt(0) lgkmcnt(0)" ::: "memory"); __syncthreads(); } while (0)

__device__ __forceinline__ float max3f(float a, float b, float c) { float r; asm("v_max3_f32 %0, %1, %2, %3" : "=v"(r) : "v"(a), "v"(b), "v"(c)); return r; }
__device__ __forceinline__ float max2f(float a, float b) { float r; asm("v_max_f32_e32 %0, %1, %2" : "=v"(r) : "v"(a), "v"(b)); return r; }
__device__ __forceinline__ float rowmax3(const f32x16& p0, const f32x16& p1) {
    float a = max3f(p0[0], p0[1], p1[0]), b = max3f(p0[2], p0[3], p1[1]); a = max3f(a, p1[2], p1[3]);
#pragma unroll
    for (int r = 4; r < 16; r += 4) { a = max3f(a, p0[r], p0[r + 1]); b = max3f(b, p0[r + 2], p0[r + 3]); a = max3f(a, p1[r], p1[r + 1]); b = max3f(b, p1[r + 2], p1[r + 3]); }
    const float m = max2f(a, b);
    auto rr = __builtin_amdgcn_permlane32_swap(__float_as_uint(m), __float_as_uint(m), false, false);
    return max2f(__uint_as_float(rr[0]), __uint_as_float(rr[1]));
}
template <int AV = 0>
__device__ __forceinline__ void qkt_c(f32x16& p0, f32x16& p1, const LAS unsigned char* Kslot, const half8 (&qr)[4], const f32x16& cin, int r32, int hi) {
    if (AV == 3) { p0 = cin; p1 = cin; return; }
    const LAS unsigned char* kb = Kslot + hi * 1024 + r32 * 16;
    half8 kf[8];
#pragma unroll
    for (int d0 = 0; d0 < 4; ++d0) { kf[2 * d0] = *(const LAS half8*)(kb + d0 * 2048); kf[2 * d0 + 1] = *(const LAS half8*)(kb + d0 * 2048 + 512); }
    __builtin_amdgcn_sched_barrier(0);
    f32x16 a = cin, b = cin;
#pragma unroll
    for (int d0 = 0; d0 < 4; ++d0) {
        a = __builtin_amdgcn_mfma_f32_32x32x16_f16(kf[2 * d0], qr[d0], a, 0, 0, 0);
        b = __builtin_amdgcn_mfma_f32_32x32x16_f16(kf[2 * d0 + 1], qr[d0], b, 0, 0, 0);
    }
    p0 = a; p1 = b;
}
struct SmState { f32x16 o[2]; float lsum; float mhat; };
__device__ __forceinline__ void sm_init(SmState& S) { S.o[0] = f32x16{}; S.o[1] = f32x16{}; S.lsum = 0.f; S.mhat = MFLOOR; }
__device__ __forceinline__ f32x16 splat16(float v) { f32x16 c;
#pragma unroll
    for (int r = 0; r < 16; ++r) c[r] = v;
    return c; }
#define MUL_IP(x, f) do { float t_ = (x); asm volatile("v_mul_f32_e32 %0, %1, %0" : "+v"(t_) : "v"(f)); (x) = t_; } while (0)
#define SUB_IP(x, d) do { float t_ = (x); asm volatile("v_sub_f32_e32 %0, %0, %1" : "+v"(t_) : "v"(d)); (x) = t_; } while (0)
#define MIN_IP(x, b) do { float t_ = (x); asm volatile("v_min_f32_e32 %0, %1, %0" : "+v"(t_) : "v"(b)); (x) = t_; } while (0)
template <int MASK>
__device__ __forceinline__ void mask_tile(f32x16& p0, f32x16& p1, int hi, int tl) {
    asm volatile("s_nop 15\n\ts_nop 7" : "+v"(p0), "+v"(p1));
    const float INF = __builtin_inff();
#pragma unroll
    for (int r = 0; r < 16; ++r) { const int kl = crow(r, hi);
        const bool k0 = (MASK == 1) ? (kl <= tl) : (kl > tl), k1 = (MASK == 1) ? (kl + 32 <= tl) : (kl + 32 > tl);
        const float b0 = k0 ? INF : NEGBIG, b1 = k1 ? INF : NEGBIG; MIN_IP(p0[r], b0); MIN_IP(p1[r], b1); }
}
template <int AV = 0>
__device__ __forceinline__ void sm_tile(f32x16& p0, f32x16& p1, SmState& S, LAS float* wsf, int r32, int hi, int vb, half8 ones) {
    asm volatile("s_nop 15\n\ts_nop 7" : "+v"(p0), "+v"(p1));
    const float rm = rowmax3(p0, p1);
    if (__any(rm > THR)) {
        const float dl = fmaxf(rm, 0.f), f = __builtin_amdgcn_exp2f(-dl); S.mhat += dl;
#pragma unroll
        for (int r = 0; r < 16; ++r) { SUB_IP(p0[r], dl); SUB_IP(p1[r], dl); }
        if (hi == 0) wsf[r32] = f;
        asm volatile("s_waitcnt lgkmcnt(0)" ::: "memory");
#pragma unroll
        for (int r = 0; r < 16; ++r) { const float fr = wsf[crow(r, hi)]; MUL_IP(S.o[0][r], fr); MUL_IP(S.o[1][r], fr); }
        S.lsum *= f;
        asm volatile("s_waitcnt lgkmcnt(0)" ::: "memory");
    }
#pragma unroll
    for (int r = 0; r < 16; ++r) { if (AV != 1) { p0[r] = __builtin_amdgcn_exp2f(p0[r]); p1[r] = __builtin_amdgcn_exp2f(p1[r]); } }
    const half8 pa0 = pack8(p0, 0), pa1 = pack8(p0, 8), pa2 = pack8(p1, 0), pa3 = pack8(p1, 8);
    if (AV != 5) { const f32x16 ps = p0 + p1;
        S.lsum += (((ps[0] + ps[1]) + (ps[2] + ps[3])) + ((ps[4] + ps[5]) + (ps[6] + ps[7]))) + (((ps[8] + ps[9]) + (ps[10] + ps[11])) + ((ps[12] + ps[13]) + (ps[14] + ps[15]))); }
    if (AV != 2) pv(S.o, vb, pa0, pa1, pa2, pa3);
    else { asm volatile("" :: "v"(pa0), "v"(pa1), "v"(pa2), "v"(pa3)); }
}
__device__ __forceinline__ void sm_scale(SmState& S, float gate, LAS float* wsf, int r32, int hi) {
    float lt = S.lsum;
    { auto rr = __builtin_amdgcn_permlane32_swap(__float_as_uint(lt), __float_as_uint(lt), false, false); lt = __uint_as_float(rr[0]) + __uint_as_float(rr[1]); }
    const float val = (lt > 0.f) ? gate * __builtin_amdgcn_rcpf(lt) : 0.f;
    if (hi == 0) wsf[r32] = val;
    asm volatile("s_waitcnt lgkmcnt(0)" ::: "memory");
#pragma unroll
    for (int r = 0; r < 16; ++r) { const float fr = wsf[crow(r, hi)]; S.o[0][r] *= fr; S.o[1][r] *= fr; }
    asm volatile("s_waitcnt lgkmcnt(0)" ::: "memory");
}
__device__ __forceinline__ void add_scaled(f32x16 (&res)[2], const f32x16 (&o)[2], float sc, LAS float* wsf, int r32, int hi) {
    if (hi == 0) wsf[r32] = sc;
    asm volatile("s_waitcnt lgkmcnt(0)" ::: "memory");
#pragma unroll
    for (int r = 0; r < 16; ++r) { const float fr = wsf[crow(r, hi)]; res[0][r] += o[0][r] * fr; res[1][r] += o[1][r] * fr; }
    asm volatile("s_waitcnt lgkmcnt(0)" ::: "memory");
}

template <int PARTS, int AV = 0>
__device__ __forceinline__ void unit(LAS unsigned char* lds, unsigned char* ws, const float* gatt, int b, int g, int qt, int tid) {
    asm volatile("" : "+v"(tid));
    asm volatile("" : "+s"(ws));
    const int lane = tid & 63, wid = __builtin_amdgcn_readfirstlane(tid >> 6), r32 = lane & 31, hi = lane >> 5, hg = wid & 3, qs = wid >> 2, h = g * 4 + hg;
    const half_t* P = (const half_t*)(ws + WS_P);
    const int tl = 32 * qs + r32;
    const int t = 64 * qt + tl; const size_t row = (size_t)b * SEQ + t;
    LAS float* wsf = (LAS float*)(lds + L_WSF) + wid * 64;
    const int vb0 = (int)(unsigned)(uintptr_t)(lds + L_VB) + ((lane >> 4) & 1) * 32 + (lane & 3) * 8 + (4 * hi + ((lane & 15) >> 2)) * 64;
    const size_t pitch = (size_t)NP * 2;
    {
        const unsigned char* kc = (const unsigned char*)(ws + WS_KCMP) + ((size_t)(b * 128) * 4 + g) * 128;
        const unsigned char* vc = (const unsigned char*)(ws + WS_VCMP) + ((size_t)(b * 128) * 4 + g) * 128;
        load_kv(lds, L_KB, L_VB, kc, vc, 512, wid, lane);
        if (qt >= 16) load_kv(lds, L_KB + 8192, L_VB + 8192, kc + 64 * 512, vc + 64 * 512, 512, wid, lane);
    }
    half8 qr[4];
    { const half_t* qp = P + row * NP + PC_Q + h * 64 + hi * 8;
#pragma unroll
      for (int d0 = 0; d0 < 4; ++d0) qr[d0] = *(const half8*)(qp + 16 * d0); }
    const half_t* glp = P + row * NP + PC_GL + h * 3;
    const float g0 = sigmoidf_((float)glp[0]), g1 = sigmoidf_((float)glp[1]), g2 = sigmoidf_((float)glp[2]);
    if (tid == 0) *(LAS unsigned*)(lds + L_UM) = 0u;
    f32x16 oc[2];
    ATT_SYNC();
    {
        const bool two = (qt >= 16);
        f32x16 s0, s1, s2, s3;
        qkt(s0, s1, lds + L_KB, qr, r32, hi);
        if (two) qkt(s2, s3, lds + L_KB + 8192, qr, r32, hi); else { s2 = splat16(NEGBIG); s3 = s2; }
        const int nvalid = (t >= 31) ? ((t - 31) / 16 + 1) : 0;
#pragma unroll
        for (int r = 0; r < 16; ++r) { const int n = crow(r, hi);
            if (n >= nvalid) s0[r] = NEGBIG; if (n + 32 >= nvalid) s1[r] = NEGBIG; if (n + 64 >= nvalid) s2[r] = NEGBIG; if (n + 96 >= nvalid) s3[r] = NEGBIG; }
        const float mc = fmaxf(fmaxf(rowmax(s0, s1), two ? rowmax(s2, s3) : NEGBIG), MFLOOR);
        float ls = 0.f;
#pragma unroll
        for (int r = 0; r < 16; ++r) { s0[r] = __builtin_amdgcn_exp2f(s0[r] - mc); s1[r] = __builtin_amdgcn_exp2f(s1[r] - mc); ls += s0[r] + s1[r]; }
        if (two) {
#pragma unroll
            for (int r = 0; r < 16; ++r) { s2[r] = __builtin_amdgcn_exp2f(s2[r] - mc); s3[r] = __builtin_amdgcn_exp2f(s3[r] - mc); ls += s2[r] + s3[r]; }
        }
        { auto rr = __builtin_amdgcn_permlane32_swap(__float_as_uint(ls), __float_as_uint(ls), false, false); ls = __uint_as_float(rr[0]) + __uint_as_float(rr[1]); }
        const float rl = (ls > 0.f) ? 1.0f / ls : 0.f;
#pragma unroll
        for (int r = 0; r < 16; ++r) { s0[r] *= rl; s1[r] *= rl; }
        if (two) {
#pragma unroll
            for (int r = 0; r < 16; ++r) { s2[r] *= rl; s3[r] *= rl; }
        }
        LAS float* imp = (LAS float*)(lds + L_IMP) + hg * 2048 + tl;
#define ATT_IMPA(S, TI, HF) _Pragma("unroll") for (int gq = 0; gq < 4; ++gq) { const int J = 16 * (TI) + 8 * (HF) + 2 * gq + hi; imp[J * 64] = (S[4 * gq] + S[4 * gq + 1]) + (S[4 * gq + 2] + 0.5f * S[4 * gq + 3]); }
        ATT_IMPA(s0, 0, 0) ATT_IMPA(s1, 0, 1)
        if (two) { ATT_IMPA(s2, 1, 0) ATT_IMPA(s3, 1, 1) }
#undef ATT_IMPA
        asm volatile("s_waitcnt lgkmcnt(0)" ::: "memory");
#define ATT_IMPB(S, TI, HF) _Pragma("unroll") for (int gq = 0; gq < 4; ++gq) { const int J = 16 * (TI) + 8 * (HF) + 2 * gq + hi + 1; if (J < 32) imp[J * 64] += 0.5f * S[4 * gq + 3]; }
        ATT_IMPB(s0, 0, 0) ATT_IMPB(s1, 0, 1)
        if (two) { ATT_IMPB(s2, 1, 0) ATT_IMPB(s3, 1, 1) }
#undef ATT_IMPB
        f32x16 o[2]; o[0] = f32x16{}; o[1] = f32x16{};
        pv(o, vb0, pack8(s0, 0), pack8(s0, 8), pack8(s1, 0), pack8(s1, 8));
        if (two) pv(o, vb0 + 8192, pack8(s2, 0), pack8(s2, 8), pack8(s3, 0), pack8(s3, 8));
        oc[0] = f32x16{}; oc[1] = f32x16{};
        add_scaled(oc, o, g0, wsf, r32, hi);
    }
    ATT_SYNC();
    if (PARTS & 1) load_kv(lds, L_KB, L_VB, (const unsigned char*)(P + (size_t)b * SEQ * NP + PC_KS + g * 64), (const unsigned char*)(P + (size_t)b * SEQ * NP + PC_VS + g * 64), pitch, wid, lane);
    {
        const int q = tid >> 3, sub = tid & 7, cur = qt; unsigned mask;
        if (cur <= 7) mask = (2u << cur) - 1u;
        else {
            const LAS float* ip = (const LAS float*)(lds + L_IMP) + q;
            float iv[4];
#pragma unroll
            for (int j = 0; j < 4; ++j) { const int J = sub * 4 + j; iv[j] = (ip[J * 64] + ip[2048 + J * 64]) + (ip[4096 + J * 64] + ip[6144 + J * 64]);
                if (J < 1 || J > cur - 2) iv[j] = -1.0f; }
            mask = 1u | (1u << cur) | (1u << (cur - 1));
            for (int rnd = 0; rnd < 5; ++rnd) {
                float bv = iv[0]; int bi = sub * 4;
#pragma unroll
                for (int j = 1; j < 4; ++j) if (iv[j] > bv) { bv = iv[j]; bi = sub * 4 + j; }
#pragma unroll
                for (int x = 1; x < 8; x <<= 1) { const float ov = __shfl_xor(bv, x); const int oi = __shfl_xor(bi, x); if (ov > bv || (ov == bv && oi < bi)) { bv = ov; bi = oi; } }
                mask |= 1u << bi;
#pragma unroll
                for (int j = 0; j < 4; ++j) if (bi == sub * 4 + j) iv[j] = -2.0f;
            }
        }
        if (sub == 0) { ((LAS unsigned*)(lds + L_MASK))[q] = mask; if ((tid & 63) == 0) {} }
        if (sub == 0) __hip_atomic_fetch_or((LAS unsigned*)(lds + L_UM), mask, __ATOMIC_RELAXED, __HIP_MEMORY_SCOPE_WORKGROUP);
    }
    ATT_SYNC();
    const unsigned msk = ((const LAS unsigned*)(lds + L_MASK))[tl];
    const unsigned um = (unsigned)__builtin_amdgcn_readfirstlane(*(const LAS unsigned*)(lds + L_UM));
    LAS float* resl = (LAS float*)(lds + L_RES) + wid * (32 * RS) + r32;
#pragma unroll
    for (int r = 0; r < 16; ++r) { resl[crow(r, hi) * RS] = oc[0][r]; resl[crow(r, hi) * RS + 32] = oc[1][r]; }
    const half8 ones = {(half_t)1.0f, (half_t)1.0f, (half_t)1.0f, (half_t)1.0f, (half_t)1.0f, (half_t)1.0f, (half_t)1.0f, (half_t)1.0f};
    if (PARTS & 1) {
        const unsigned char* kbase = (const unsigned char*)(P + (size_t)b * SEQ * NP + PC_KS + g * 64);
        const unsigned char* vbase = (const unsigned char*)(P + (size_t)b * SEQ * NP + PC_VS + g * 64);
        SmState S; sm_init(S);
        const int NT = __builtin_popcount(um);
        unsigned rem = um; int kt = __builtin_ctz(rem); rem &= rem - 1u;
        int n1 = rem ? __builtin_ctz(rem) : 0; rem &= rem - 1u;
        int n2 = rem ? __builtin_ctz(rem) : 0; rem &= rem - 1u;
        if (NT > 1) load_kv(lds, L_KB + 8192, L_VB + 8192, kbase + (size_t)n1 * 64 * pitch, vbase + (size_t)n1 * 64 * pitch, pitch, wid, lane);
        int sc = 0, sn = 16384;
        for (int i = 0; i < NT; ++i) {
            ATT_RING_SYNC(NT - 1 - i);
            if (i + 2 < NT && AV != 4) load_kv(lds, L_KB + sn, L_VB + sn, kbase + (size_t)n2 * 64 * pitch, vbase + (size_t)n2 * 64 * pitch, pitch, wid, lane);
            const bool bit = (msk >> kt) & 1u;
            if (__any(bit)) {
                f32x16 p0, p1; qkt_c<AV>(p0, p1, lds + L_KB + sc, qr, splat16(bit ? -S.mhat : NEGBIG), r32, hi);
                if (kt == qt) mask_tile<1>(p0, p1, hi, tl);
                sm_tile<AV>(p0, p1, S, wsf, r32, hi, vb0 + sc, ones);
            }
            kt = n1; n1 = n2; n2 = rem ? __builtin_ctz(rem) : 0; rem &= rem - 1u;
            sc = (sc == 16384) ? 0 : sc + 8192; sn = (sn == 16384) ? 0 : sn + 8192;
        }
        sm_scale(S, g1, wsf, r32, hi);
#pragma unroll
        for (int r = 0; r < 16; ++r) { resl[crow(r, hi) * RS] += S.o[0][r]; resl[crow(r, hi) * RS + 32] += S.o[1][r]; }
    }
    ATT_SYNC();
    if (PARTS & 2) {
        const unsigned char* kbase = (const unsigned char*)(P + (size_t)b * SEQ * NP + PC_KW + g * 64);
        const unsigned char* vbase = (const unsigned char*)(P + (size_t)b * SEQ * NP + PC_VW + g * 64);
        SmState S; sm_init(S);
        const int kt0 = qt >= 8 ? qt - 8 : 0, NT = qt - kt0 + 1;
        kbase += (size_t)kt0 * 64 * pitch; vbase += (size_t)kt0 * 64 * pitch;
        load_kv(lds, L_KB, L_VB, kbase, vbase, pitch, wid, lane);
        if (NT > 1) load_kv(lds, L_KB + 8192, L_VB + 8192, kbase + (size_t)64 * pitch, vbase + (size_t)64 * pitch, pitch, wid, lane);
        int sc = 0, sn = 16384;
        for (int i = 0; i < NT; ++i) {
            ATT_RING_SYNC(NT - 1 - i);
            if (i + 2 < NT && AV != 4) load_kv(lds, L_KB + sn, L_VB + sn, kbase + (size_t)(i + 2) * 64 * pitch, vbase + (size_t)(i + 2) * 64 * pitch, pitch, wid, lane);
            const int kt = kt0 + i;
            f32x16 p0, p1; qkt_c<AV>(p0, p1, lds + L_KB + sc, qr, splat16(-S.mhat), r32, hi);
            if (kt == qt) mask_tile<1>(p0, p1, hi, tl);
            else if (kt == qt - 8) mask_tile<2>(p0, p1, hi, tl);
            sm_tile<AV>(p0, p1, S, wsf, r32, hi, vb0 + sc, ones);
            sc = (sc == 16384) ? 0 : sc + 8192; sn = (sn == 16384) ? 0 : sn + 8192;
        }
        sm_scale(S, g2, wsf, r32, hi);
#pragma unroll
        for (int r = 0; r < 16; ++r) { resl[crow(r, hi) * RS] += S.o[0][r]; resl[crow(r, hi) * RS + 32] += S.o[1][r]; }
        asm volatile("s_waitcnt lgkmcnt(0)" ::: "memory");
        {
            const int kc = lane & 7;
            const float* gp = gatt + h * 64 + 8 * kc;
            const f32x4 g0 = *(const f32x4*)(gp), g1 = *(const f32x4*)(gp + 4);
#pragma unroll
            for (int jj = 0; jj < 4; ++jj) {
                const int orow = 8 * jj + (lane >> 3);
                const LAS float* rp = (const LAS float*)(lds + L_RES) + wid * (32 * RS) + orow * RS + 8 * kc;
                const size_t rowg = (size_t)b * SEQ + 64 * qt + 32 * qs + orow;
                const f32x4 v0 = *(const LAS f32x4*)(rp), v1 = *(const LAS f32x4*)(rp + 4);
                float ss = (v0[0] * v0[0] + v0[1] * v0[1]) + (v0[2] * v0[2] + v0[3] * v0[3]) + (v1[0] * v1[0] + v1[1] * v1[1]) + (v1[2] * v1[2] + v1[3] * v1[3]);
                u32x4 w; w.x = pk2x<FFN_DT>(v0[0] * g0[0], v0[1] * g0[1]); w.y = pk2x<FFN_DT>(v0[2] * g0[2], v0[3] * g0[3]); w.z = pk2x<FFN_DT>(v1[0] * g1[0], v1[1] * g1[1]); w.w = pk2x<FFN_DT>(v1[2] * g1[2], v1[3] * g1[3]);
                if (AV == 0) *(u32x4*)((half_t*)(ws + WS_AMIX) + rowg * 2048 + h * 64 + 8 * kc) = w; else asm volatile("" :: "v"(w));
                ss += __shfl_xor(ss, 1); ss += __shfl_xor(ss, 2); ss += __shfl_xor(ss, 4);
                if (kc == 0 && AV == 0) atomicAdd((float*)(ws + WS_CTL) + CW_SSA + rowg, ss); else asm volatile("" :: "v"(ss));
            }
        }
    }
    ATT_SYNC();
}
#undef ATT_SBAR
#undef ATT_SYNC
}

template <int AV = 0>
__device__ __forceinline__ void p5_attn(Frame& F) {
    if (F.G == 256 && AV == 0) {
        const int xq = F.vcu >> 5;
        unsigned* qc = (unsigned*)(F.ws + WS_CTL) + CW_ATTQ + 64 * xq;
        volatile LAS unsigned* slot = (volatile LAS unsigned*)(F.lds + MISC_OFF + 64);
        const bool lead = (F.wv == 0) && (lane_id() == 0);
        unsigned nxt = 0u;
        if (lead) { nxt = __hip_atomic_fetch_add(qc, 1u, __ATOMIC_RELAXED, __HIP_MEMORY_SCOPE_AGENT); *slot = nxt; }
        __syncthreads();
        unsigned cur = (unsigned)__builtin_amdgcn_readfirstlane(*slot);
        while (cur < 128u) {
            if (lead) nxt = __hip_atomic_fetch_add(qc, 1u, __ATOMIC_RELAXED, __HIP_MEMORY_SCOPE_AGENT);
            const int qt = 31 - (int)(cur >> 2), bg = 4 * xq + (int)(cur & 3u);
            att::unit<3, 0>(F.lds, F.ws, get_args()->in[I_GATT], bg >> 2, bg & 3, qt, make_tid(F.wv));
            if (lead) *slot = nxt;
            __syncthreads();
            cur = (unsigned)__builtin_amdgcn_readfirstlane(*slot);
        }
        return;
    }
    for (int v = F.vcu; v < 256; v += F.G) {
        const int bg = v >> 3, s = v & 7;
        const unsigned qpack = (s == 0) ? 0x0110111fu : (s == 1) ? 0x000e161du : (s == 2) ? 0x020d121eu : (s == 3) ? 0x030c171au : (s == 4) ? 0x0409141cu : (s == 5) ? 0x050a131bu : (s == 6) ? 0x06071519u : 0x080b0f18u;
        for (int i = 0; i < 4; ++i) { const int qt = (int)((qpack >> (8 * i)) & 0xffu);
            att::unit<(AV == 7) ? 0 : (AV == 8) ? 1 : 3, AV>(F.lds, F.ws, get_args()->in[I_GATT], bg >> 2, bg & 3, qt, make_tid(F.wv)); }
    }
}

constexpr int NPHASES = 13;
__global__ void __launch_bounds__(NWAVES * 64, 2) mega_fwd(Args args_unused) {
    extern __shared__ __attribute__((aligned(16))) unsigned char lds_raw[];
    Frame F;
    ArgsP args = get_args();
    F.lds = (LAS unsigned char*)lds_raw; F.ws = args->ws;
    F.wv = __builtin_amdgcn_readfirstlane((int)threadIdx.x >> 6);
    F.G = gridDim.x; { const int bx = blockIdx.x; F.vcu = (F.G % 8 == 0) ? (bx % 8) * (F.G / 8) + bx / 8 : bx; }
    volatile LAS unsigned* MISC = (volatile LAS unsigned*)(F.lds + MISC_OFF);
    for (int u = make_tid(F.wv); u < (LDS_BYTES - LDSCTL_OFF) / 4; u += NWAVES * 64) ((LAS unsigned*)(F.lds + LDSCTL_OFF))[u] = 0u;
    __syncthreads();
    gu32* ctl = (gu32*)(F.ws + WS_CTL);
    XcdBarrier bar; bar.bar = (unsigned*)(ctl + CW_BAR); bar.x = 0; bar.st = nullptr; bar.wv = F.wv;
    const int lo = args->ph_lo, hi = args->ph_hi;
    const bool multi = (hi - lo) > 1;
    if (multi) bar = xcd_barrier_post((unsigned*)(ctl + CW_BAR), MISC + 8, F.wv);
#define IN(k) (lo <= (k) && (k) < hi)
#define REP(k) for (int rep_ = 0; rep_ < ((((PROBE_REP) >> (k)) & 1) ? 2 : 1); ++rep_)
#define SEAM(k) do { if (IN(k) && IN((k) + 1)) xcd_barrier(bar); } while (0)
    unsigned char* ws = F.ws;

    if (IN(0)) REP(0) { p0_prologue(F, rep_); } SEAM(0);
    if (IN(1)) REP(1) { p1_norm(F); } SEAM(1);
    const bool p3_in_p2 = (F.G == 256);
    if (IN(2)) REP(2) {
        pg8::GeoPlain g{(const half_t*)(ws + WS_HBUF), (const half_t*)(ws + WS_WIN), DM, DM};
        if (p3_in_p2) {
            pg8::ProjOrder S; S.init(NTOK / 256, NP / 256, F.G, (int)blockIdx.x); S.cnt = (unsigned*)(ws + WS_CTL) + CW_P2CNT; S.wv = F.wv;
            pg8::EpiF16<3> E{(half_t*)(ws + WS_P), NP, nullptr};
            pg8::gemm_phase<pg8::GeoPlain, pg8::EpiF16<3>, pg8::ProjOrder, true, true, PROJ_DT>(F.lds, g, S, E, F.wv);
            const int c = (int)blockIdx.x, busy = ((NTOK / 256) * (NP / 256)) % 256;
            if (c >= busy) {
                const int gid = c & 7, j = (c - busy) >> 3;
                if (F.wv == 0) { unsigned* cn = (unsigned*)(ws + WS_CTL) + CW_P2CNT + 64 * gid; unsigned sp = 0;
                    while ((unsigned)__builtin_amdgcn_readfirstlane(__hip_atomic_load(cn, __ATOMIC_RELAXED, __HIP_MEMORY_SCOPE_AGENT)) < 32u) { __builtin_amdgcn_s_sleep(4); if (++sp > (1u << 22)) break; }
                    __builtin_amdgcn_fence(__ATOMIC_ACQUIRE, "agent"); asm volatile("s_waitcnt vmcnt(0)" ::: "memory"); }
                __syncthreads();
                p3_conv(F, gid * 256 + j * 32, gid * 256 + j * 32 + 32, F.wv, NWAVES);
                __syncthreads();
                pg8::GeoCmp gc{(const half_t*)(ws + WS_P), (const half_t*)(ws + WS_WC1)};
                pg8::ListOrder L{j, 1, 2 * gid, 4};
                pg8::EpiSlab Es{(float*)(ws + WS_SLAB)};
                pg8::gemm_phase<pg8::GeoCmp, pg8::EpiSlab, pg8::ListOrder, true, true>(F.lds, gc, L, Es, F.wv);
            }
        } else {
            pg8::StaticOrder S; S.init(NTOK / 256, NP / 256, F.G, (int)blockIdx.x);
            pg8::EpiF16<3> E{(half_t*)(ws + WS_P), NP, nullptr};
            pg8::gemm_phase<pg8::GeoPlain, pg8::EpiF16<3>, pg8::StaticOrder, true, true, PROJ_DT>(F.lds, g, S, E, F.wv);
        }
    } SEAM(2);
    if (IN(3) && !p3_in_p2) REP(3) {
        p3_conv(F, 0, NTOK / 8, F.vcu * NWAVES + F.wv, F.G * NWAVES);
        __syncthreads();
        pg8::GeoCmp g{(const half_t*)(ws + WS_P), (const half_t*)(ws + WS_WC1)};
        pg8::StaticOrder S; S.init(16, 4, F.G, (int)blockIdx.x);
        pg8::EpiSlab E{(float*)(ws + WS_SLAB)};
        pg8::gemm_phase<pg8::GeoCmp, pg8::EpiSlab, pg8::StaticOrder, true, true>(F.lds, g, S, E, F.wv);
    }
    if (!p3_in_p2) SEAM(3);
    if (IN(4)) REP(4) {
        pg8::GeoGates g{(const half_t*)(ws + WS_XC), (const half_t*)(ws + WS_WRG)};
        pg8::StaticOrder S; S.init(NTOK / 256, 8, F.G, (int)blockIdx.x);
        ArgsP ap = get_args();
        { LAS float* tab = (LAS float*)(F.lds + pg8::XTAB_OFF); const float* sp8 = (const float*)(ws + WS_SP8);
          for (int i = make_tid(F.wv); i < 3072; i += NWAVES * 64) tab[i] = (i < 1024) ? ap->in[I_BRGA][i] : (i < 2048) ? ap->in[I_BRGX][i - 1024] : sp8[i - 2048];
          __syncthreads(); }
        pg8::EpiGates E{(const half_t*)(ws + WS_XC), (const LAS float*)(F.lds + pg8::XTAB_OFF), (unsigned*)(ws + WS_ABUF)};
        pg8::gemm_phase<pg8::GeoGates, pg8::EpiGates, pg8::StaticOrder, true, true>(F.lds, g, S, E, F.wv);
        __syncthreads();
        p4_cmp2(F);
    } SEAM(4);
    if (IN(5)) { for (int r_ = 0; r_ <= PROBE_SCAN; ++r_) { p5_scan(F); __syncthreads(); } p5_attn<0>(F);
#if PROBE_ATT
        p5_attn<PROBE_AV>(F);
#endif
    } SEAM(5);
    if (IN(8)) REP(8) {
        pg8::GeoPlain g{(const half_t*)(ws + WS_AMIX), (const half_t*)(ws + WS_WOUT), DM, DM};
        pg8::PanelOrder S{F.vcu};
        pg8::PanelXchg x1{(float*)(ws + WS_XSLOT), (unsigned*)(ws + WS_CTL) + CW_PANEL}, x2{(float*)(ws + WS_XSLOT) + (size_t)NTOK * 8, (unsigned*)(ws + WS_CTL) + CW_PANEL + 4096};
        pg8::EpiX1H2 E{(const float*)(ws + WS_PAR), (half_t*)(ws + WS_X1H), (half_t*)(ws + WS_H2), x1, x2, (const float*)(ws + WS_CTL) + CW_SSA, (const float*)(ws + WS_CTL) + CW_SSR};
        pg8::gemm_phase<pg8::GeoPlain, pg8::EpiX1H2, pg8::PanelOrder, true, true, FFN_DT>(F.lds, g, S, E, F.wv);
    } SEAM(8);
    if (IN(10)) REP(10) {
        pg8::GeoPlain g{(const half_t*)(ws + WS_H2), (const half_t*)(ws + WS_WFF1), DM, DM};
        pg8::StaticOrder S; S.init(NTOK / 256, DFF / 256, F.G, (int)blockIdx.x);
        pg8::EpiF16<1, FFN_DT> E{(half_t*)(ws + WS_U), DFF, nullptr};
        pg8::gemm_phase<pg8::GeoPlain, pg8::EpiF16<1, FFN_DT>, pg8::StaticOrder, true, true, FFN_DT>(F.lds, g, S, E, F.wv);
    } SEAM(10);
    if (IN(11)) REP(11) {
        ArgsP ap = get_args();
        pg8::GeoPlain g{(const half_t*)(ws + WS_U), (const half_t*)(ws + WS_WFF2), DFF, DFF};
        pg8::PanelOrder S{F.vcu};
        pg8::PanelXchg xs{(float*)(ws + WS_XSLOT) + (size_t)NTOK * 16, (unsigned*)(ws + WS_CTL) + CW_PANEL + 8192};
        pg8::EpiFinal E{(const half_t*)(ws + WS_X1H), (const float*)(ws + WS_PAR), ap->out, xs};
        pg8::gemm_phase<pg8::GeoPlain, pg8::EpiFinal, pg8::PanelOrder, true, true, FFN_DT>(F.lds, g, S, E, F.wv);
    }
#undef IN
#undef SEAM
}

extern "C" void kernel_launch(void* const* d_in, const int* in_sizes, int n_in, void* d_out, int out_size, void* d_ws, size_t ws_size, hipStream_t stream) {
    static int grid = 0;
    if (grid == 0) {
        if (n_in != 27 || in_sizes[0] != NTOK * DM || out_size != NTOK * DM || ws_size < WS_END) { fprintf(stderr, "kernel_launch: unexpected shapes (n_in %d, in0 %d, out %d, ws %zu); nothing launched\n", n_in, n_in > 0 ? in_sizes[0] : -1, out_size, ws_size); grid = -1; return; }
        int dev = 0, cus = 0, per_cu = 0;
        if (hipGetDevice(&dev) != hipSuccess || hipDeviceGetAttribute(&cus, hipDeviceAttributeMultiprocessorCount, dev) != hipSuccess) { grid = -1; return; }
        if (hipFuncSetAttribute((const void*)mega_fwd, hipFuncAttributeMaxDynamicSharedMemorySize, LDS_BYTES) != hipSuccess) { fprintf(stderr, "kernel_launch: hipFuncSetAttribute failed\n"); grid = -1; return; }
        if (hipOccupancyMaxActiveBlocksPerMultiprocessor(&per_cu, (const void*)mega_fwd, NWAVES * 64, LDS_BYTES) != hipSuccess || per_cu < 1) { fprintf(stderr, "kernel_launch: occupancy query says %d\n", per_cu); }
        (void)hipGetLastError();
        grid = cus;
    }
    if (grid < 0) return;
    if (hipMemsetAsync((char*)d_ws + WS_CTL, 0, CTL_ZERO_BYTES, stream) != hipSuccess) return;
    Args a{};
    for (int i = 0; i < 27; ++i) a.in[i] = (const float*)d_in[i];
    a.out = (float*)d_out; a.ws = (unsigned char*)d_ws;
#if MK_N_LAUNCHES == 1
    a.ph_lo = 0; a.ph_hi = NPHASES;
    hipLaunchKernelGGL(mega_fwd, dim3(grid), dim3(NWAVES * 64), LDS_BYTES, stream, a);
#else
    for (int p = 0; p < NPHASES; ++p) { a.ph_lo = p; a.ph_hi = p + 1; hipLaunchKernelGGL(mega_fwd, dim3(grid), dim3(NWAVES * 64), LDS_BYTES, stream, a); }
#endif
}
```

```cpp
#include <hip/hip_runtime.h>
#include <cstdio>
#include <cstdint>

#ifndef MK_N_LAUNCHES
#define MK_N_LAUNCHES 1
#endif

#ifndef PROBE_REP
#define PROBE_REP 0
#endif
#ifndef PROBE_TM
#define PROBE_TM 0
#endif
#ifndef PROBE_P0X
#define PROBE_P0X 0
#endif
#ifndef PROBE_BAR
#define PROBE_BAR 0
#endif
#ifndef PROBE_ATTP
#define PROBE_ATTP 0
#endif
#ifndef PROBE_SCAN
#define PROBE_SCAN 0
#endif
#ifndef PROBE_AV
#define PROBE_AV 0
#endif
#ifndef PROBE_ATT
#define PROBE_ATT 0
#endif
#define GAS __attribute__((address_space(1)))
#define LAS __attribute__((address_space(3)))
typedef _Float16 half_t;
typedef _Float16 half8 __attribute__((ext_vector_type(8)));
typedef _Float16 half4 __attribute__((ext_vector_type(4)));
typedef _Float16 half2v __attribute__((ext_vector_type(2)));
typedef float f32x4 __attribute__((ext_vector_type(4)));
typedef float f32x2 __attribute__((ext_vector_type(2)));
typedef unsigned u32x4 __attribute__((ext_vector_type(4)));
typedef unsigned u32x2 __attribute__((ext_vector_type(2)));

constexpr int NB = 8, SEQ = 2048, NTOK = NB * SEQ, DM = 2048, DFF = 8192;
constexpr int NPROJ = 4656, NP = 4864;
constexpr int PC_Q = 0, PC_KC = 1024, PC_VC = 1280, PC_KS = 1536, PC_VS = 1792, PC_KW = 2048, PC_VW = 2304, PC_XR = 2560, PC_YR = 3584, PC_GL = 4608;
constexpr float EPS = 1e-6f;
#ifndef FFN_BF16
#define FFN_BF16 1
#endif
constexpr int FFN_DT = FFN_BF16;
constexpr int PROJ_DT = 1;
constexpr float QSC = 0.125f * 1.4426950408889634f;

constexpr size_t MiB = 1u << 20;
constexpr size_t WS_CTL = 0, CTL_ZERO_BYTES = 1 * MiB;
constexpr size_t WS_MOD = 1 * MiB;
constexpr size_t WS_SELMASK = 1 * MiB + 512 * 1024;
constexpr size_t WS_SP8 = 1 * MiB + 448 * 1024;
constexpr size_t WS_KCMP = 2 * MiB;
constexpr size_t WS_VCMP = 2 * MiB + 512 * 1024;
constexpr size_t WS_WFF2 = 4 * MiB;
constexpr size_t WS_WFF1 = 36 * MiB;
constexpr size_t WS_WIN = 68 * MiB;
constexpr size_t WS_WOUT = 87 * MiB;
constexpr size_t WS_WC1 = 95 * MiB;
constexpr size_t WS_WRG = 97 * MiB;
constexpr size_t WS_HBUF = 100 * MiB;
constexpr size_t WS_P = 164 * MiB;
constexpr size_t WS_XC = 317 * MiB;
constexpr size_t WS_HID = 349 * MiB;
constexpr size_t WS_ABUF = 353 * MiB;
constexpr size_t WS_BTBUF = 417 * MiB;
constexpr size_t WS_MIXBUF = 164 * MiB;
constexpr size_t WS_U = 68 * MiB;
constexpr size_t WS_AMIX = 100 * MiB;
constexpr size_t WS_H2 = 356 * MiB;
constexpr size_t WS_FBUF = 36 * MiB;
constexpr size_t WS_X1H = 420 * MiB;
constexpr size_t WS_XSLOT = 484 * MiB;
constexpr size_t WS_PAR = 3 * MiB;
constexpr size_t WS_SLAB = 486 * MiB;
constexpr size_t WS_END = 502 * MiB;
constexpr int CW_TMO = 0;
constexpr int CW_BAR = 4096;
constexpr int CW_BIAS1 = 16384;
constexpr int CW_SSA = 65536, CW_SSR = 81920;
constexpr int CW_P2CNT = 24576;
constexpr int CW_P0Q = 28160;
constexpr int CW_ATTQ = 28672;
constexpr int CW_PANEL = 32768;

#define RLX_AGENT __ATOMIC_RELAXED, __HIP_MEMORY_SCOPE_AGENT
#define LDS_WAIT() asm volatile("s_waitcnt lgkmcnt(0)" ::: "memory")
#define VM_WAIT() asm volatile("s_waitcnt vmcnt(0)" ::: "memory")
typedef GAS unsigned gu32;

__device__ __forceinline__ unsigned pk2h(float lo, float hi) { f32x2 v = {lo, hi}; half2v h = __builtin_convertvector(v, half2v); return __builtin_bit_cast(unsigned, h); }
typedef __bf16 bf16x2_t __attribute__((ext_vector_type(2)));
typedef short bf16x8 __attribute__((ext_vector_type(8)));
__device__ __forceinline__ unsigned pk2b(float lo, float hi) { f32x2 v = {lo, hi}; bf16x2_t b = __builtin_convertvector(v, bf16x2_t); return __builtin_bit_cast(unsigned, b); }
template <int DT> __device__ __forceinline__ unsigned pk2x(float lo, float hi) { return DT ? pk2b(lo, hi) : pk2h(lo, hi); }
__device__ __forceinline__ float wave_sum(float v) {
#pragma unroll
    for (int o = 1; o < 64; o <<= 1) v += __shfl_xor(v, o);
    return v;
}
__device__ __forceinline__ float fast_exp(float x) { return __builtin_amdgcn_exp2f(x * 1.4426950408889634f); }
__device__ __forceinline__ float sigmoidf_(float x) { return __builtin_amdgcn_rcpf(1.0f + fast_exp(-x)); }
__device__ __forceinline__ float gelu_tanh(float x) {
    const float u = 1.5957691216057308f * (x + 0.044715f * x * x * x);
    return x * __builtin_amdgcn_rcpf(1.0f + fast_exp(-u));
}
__device__ __forceinline__ float siluf_(float x) { return x / (1.0f + __expf(-x)); }

__device__ __forceinline__ int lane_id() { int l; asm volatile("v_mbcnt_lo_u32_b32 %0, -1, 0\n\tv_mbcnt_hi_u32_b32 %0, -1, %0" : "=v"(l)); return l; }
__device__ __forceinline__ int make_tid(int wv) { return wv * 64 + lane_id(); }

namespace pg8 {
constexpr int XTAB_OFF = 131072 + 1024;
constexpr int BM = 256, BK = 64, HALF = 128, HTB = HALF * BK * 2, STAGE_BYTES = 8 * HTB, NXCD = 8, WGM = 8;
__host__ __device__ __forceinline__ int lds_byte(int r, int c) { const int st = (r >> 4) * 2 + (c >> 5), rr = r & 15, cc = c & 31, ob = rr * 64 + cc * 2; return st * 1024 + (ob ^ (((ob >> 9) & 1) << 5)); }
__host__ __device__ __forceinline__ void stage_rc(int b, int& R, int& C) { const int st = b / 1024, sb = b % 1024, swz = sb ^ (((sb >> 9) & 1) << 5); R = (st >> 1) * 16 + swz / 64; C = (st & 1) * 32 + (swz % 64) / 2; }
__host__ __device__ __forceinline__ int perm32(int rho) { const int n = rho >> 4, i = rho & 15; return 8 * (i >> 2) + 4 * n + (i & 3); }

struct Unit { int pm, pn; };

struct StaticOrder {
    int nM, nN, nwg, G, c;
    __device__ void init(int nM_, int nN_, int G_, int c_) { nM = nM_; nN = nN_; nwg = nM * nN; G = G_; c = c_; }
    __device__ bool next(int i, Unit& u) const {
        const long L = (long)i * G + c; if (L >= nwg) return false;
        int wgid = (int)L; { const int q = nwg / NXCD, r = nwg % NXCD, xcd = wgid % NXCD, off = wgid / NXCD; wgid = (xcd < r ? xcd * (q + 1) : r * (q + 1) + (xcd - r) * q) + off; }
        const int nig = WGM * nN, gid = wgid / nig, fm = gid * WGM, gsz = (nM - fm) < WGM ? (nM - fm) : WGM;
        u.pm = fm + ((wgid % nig) % gsz); u.pn = (wgid % nig) / gsz; return true;
    }
};

struct GeoPlain {
    const half_t* A; const half_t* Bt; int lda, K;
    __device__ __forceinline__ int nt() const { return K / BK; }
    __device__ __forceinline__ unsigned voffA(int R, int C) const { return (unsigned)(R * lda + C) * 2u; }
    __device__ __forceinline__ size_t kstepA() const { return (size_t)BK * 2; }
    __device__ __forceinline__ size_t hstepA() const { return (size_t)HALF * lda * 2; }
    __device__ __forceinline__ const char* a_base(const Unit& u) const { return (const char*)A + (size_t)u.pm * BM * lda * 2; }
    __device__ __forceinline__ int ldb() const { return K; }
    __device__ __forceinline__ const char* b_base(const Unit& u) const { return (const char*)Bt + (size_t)u.pn * BM * K * 2; }
};
struct GeoGates {
    const half_t* A; const half_t* Bt;
    __device__ __forceinline__ int nt() const { return 2; }
    __device__ __forceinline__ unsigned voffA(int R, int C) const { return (unsigned)(R * 1024 + C) * 2u; }
    __device__ __forceinline__ size_t kstepA() const { return (size_t)BK * 2; }
    __device__ __forceinline__ size_t hstepA() const { return (size_t)HALF * 1024 * 2; }
    __device__ __forceinline__ const char* a_base(const Unit& u) const { return (const char*)A + ((size_t)u.pm * BM * 1024 + (size_t)u.pn * 128) * 2; }
    __device__ __forceinline__ int ldb() const { return 128; }
    __device__ __forceinline__ const char* b_base(const Unit& u) const { return (const char*)Bt + (size_t)u.pn * BM * 128 * 2; }
};
struct GeoCmp {
    const half_t* P; const half_t* Bt;
    __device__ __forceinline__ int nt() const { return 16; }
    __device__ __forceinline__ unsigned voffA(int R, int C) const { return (unsigned)((16 * (R >> 2)) * NP + (R & 3) * 64 + C) * 2u; }
    __device__ __forceinline__ size_t kstepA() const { return (size_t)NP * 2; }
    __device__ __forceinline__ size_t hstepA() const { return (size_t)(16 * 32) * NP * 2; }
    __device__ __forceinline__ const char* a_base(const Unit& u) const { const int b = u.pm >> 1, nb = (u.pm & 1) * 64, kv = u.pn & 1, ks = u.pn >> 1; return (const char*)P + ((size_t)(b * SEQ + 16 * nb + 16 * ks) * NP + (kv ? PC_VC : PC_KC)) * 2; }
    __device__ __forceinline__ int ldb() const { return 2048; }
    __device__ __forceinline__ const char* b_base(const Unit& u) const { const int kv = u.pn & 1, ks = u.pn >> 1; return (const char*)Bt + ((size_t)kv * BM * 2048 + (size_t)ks * 1024) * 2; }
};

template <int ACT  , int DT = 0  > struct EpiF16 {
    static constexpr bool PERM = true;
    half_t* O; int ldc; const float* bias;
    __device__ __forceinline__ void operator()(const f32x4 (&acc)[2][2][4][2], const Unit& u, int wr, int wc, int fr, int fq) const {
        const int row0 = u.pm * BM + wr * 64 + fr; const int col0 = u.pn * BM + wc * 32 + 8 * fq;
        f32x4 bv[2][2];
#pragma unroll
        for (int bj = 0; bj < 2; ++bj)
#pragma unroll
            for (int n = 0; n < 2; ++n) bv[bj][n] = (ACT == 2) ? *(const f32x4*)(bias + col0 + bj * HALF + 4 * n) : (f32x4){0.f, 0.f, 0.f, 0.f};
#pragma unroll
        for (int ai = 0; ai < 2; ++ai)
#pragma unroll
            for (int m = 0; m < 4; ++m) { half_t* rowp = O + (size_t)(row0 + ai * HALF + m * 16) * ldc + col0;
#pragma unroll
                for (int bj = 0; bj < 2; ++bj) { f32x4 v0 = acc[ai][bj][m][0] + bv[bj][0], v1 = acc[ai][bj][m][1] + bv[bj][1];
                    if (ACT == 1) {
#pragma unroll
                        for (int e = 0; e < 4; ++e) { const float a = fmaxf(v0[e], 0.f), b = fmaxf(v1[e], 0.f); v0[e] = a * a; v1[e] = b * b; } }
                    if (ACT == 2) {
#pragma unroll
                        for (int e = 0; e < 4; ++e) { v0[e] = gelu_tanh(v0[e]); v1[e] = gelu_tanh(v1[e]); } }
                    if (ACT == 3) { if (u.pn < 4) { v0 = v0 * QSC; v1 = v1 * QSC; } }
                    u32x4 w; w.x = pk2x<DT>(v0[0], v0[1]); w.y = pk2x<DT>(v0[2], v0[3]); w.z = pk2x<DT>(v1[0], v1[1]); w.w = pk2x<DT>(v1[2], v1[3]);
                    *(u32x4*)(rowp + bj * HALF) = w; } }
    }
};
struct EpiF32 {
    static constexpr bool PERM = false;
    float* C; int ldc;
    __device__ __forceinline__ void operator()(const f32x4 (&acc)[2][2][4][2], const Unit& u, int wr, int wc, int fr, int fq) const {
        const int row0 = u.pm * BM + wr * 64 + fr, col0 = u.pn * BM + wc * 32 + 4 * fq;
#pragma unroll
        for (int ai = 0; ai < 2; ++ai)
#pragma unroll
            for (int m = 0; m < 4; ++m) { float* rowp = C + (size_t)(row0 + ai * HALF + m * 16) * ldc + col0;
#pragma unroll
                for (int bj = 0; bj < 2; ++bj)
#pragma unroll
                    for (int n = 0; n < 2; ++n) *(f32x4*)(rowp + bj * HALF + n * 16) = acc[ai][bj][m][n]; }
    }
};
struct EpiSlab {
    static constexpr bool PERM = false;
    float* C;
    __device__ __forceinline__ void operator()(const f32x4 (&acc)[2][2][4][2], const Unit& u, int wr, int wc, int fr, int fq) const {
        const int row0 = u.pm * BM + wr * 64 + fr, col0 = (u.pn & 1) * BM + wc * 32 + 4 * fq; float* base = C + (size_t)(u.pn >> 1) * 4096 * 512;
#pragma unroll
        for (int ai = 0; ai < 2; ++ai)
#pragma unroll
            for (int m = 0; m < 4; ++m) { float* rowp = base + (size_t)(row0 + ai * HALF + m * 16) * 512 + col0;
#pragma unroll
                for (int bj = 0; bj < 2; ++bj)
#pragma unroll
                    for (int n = 0; n < 2; ++n) *(f32x4*)(rowp + bj * HALF + n * 16) = acc[ai][bj][m][n]; }
    }
};
struct EpiGates {
    static constexpr bool PERM = false;
    const half_t* xc; const LAS float* tab; unsigned* ab;
    __device__ __forceinline__ void operator()(const f32x4 (&acc)[2][2][4][2], const Unit& u, int wr, int wc, int fr, int fq) const {
        const int row0 = u.pm * BM + wr * 64 + fr, ch0 = u.pn * 128 + wc * 32 + 4 * fq;
#define EG_XC(k1) (*(const half4*)(xc + (unsigned)(row0 + ((k1) >> 3) * HALF + (((k1) >> 1) & 3) * 16) * 1024u + ch0 + ((k1) & 1) * 16))
        half4 xq[4];
#pragma unroll
        for (int k1 = 0; k1 < 4; ++k1) xq[k1] = EG_XC(k1);
#pragma unroll
        for (int k = 0; k < 16; ++k) { const int ai = k >> 3, m = (k >> 1) & 3, n = k & 1; const unsigned rowo = (unsigned)(row0 + ai * HALF + m * 16) * 1024u; const int ch = ch0 + n * 16;
            const half4 xh = xq[k & 3];
            if (k + 4 < 16) xq[k & 3] = EG_XC(k + 4);
            const f32x4 ba = *(const LAS f32x4*)(tab + ch), bx = *(const LAS f32x4*)(tab + 1024 + ch), sp = *(const LAS f32x4*)(tab + 2048 + ch);
            __builtin_amdgcn_sched_barrier(0);
            u32x4 pk;
#pragma unroll
            for (int e = 0; e < 4; ++e) { const float r = sigmoidf_(acc[ai][0][m][n][e] + ba[e]), ig = sigmoidf_(acc[ai][1][m][n][e] + bx[e]);
                const float a = __builtin_amdgcn_exp2f(-(r * sp[e]) * 1.4426950408889634f), om = 1.0f - a;
                pk[e] = pk2h(om, __builtin_amdgcn_sqrtf(om * (1.0f + a)) * (ig * (float)xh[e])); }
            *(u32x4*)(ab + rowo + ch) = pk;
            if (n == 1) { asm volatile("" ::: "memory"); __builtin_amdgcn_sched_barrier(0); } }
#undef EG_XC
    }
};

struct PanelOrder {
    int v;
    __device__ bool next(int i, Unit& u) const { if (i >= 2) return false; u.pm = i * 32 + (v >> 3); u.pn = v & 7; return true; }
};
struct PanelXchg {
    float* slots;
    unsigned* cnt;
    __device__ __forceinline__ void run(const f32x4 (&v)[2][2][4][2], const Unit& u, int wr, int wc, int fr, int fq, LAS unsigned char* tab, int wid, int lane) const {
        LAS float* Pt = (LAS float*)tab; LAS float* St = (LAS float*)(tab + 4096);
#pragma unroll
        for (int ai = 0; ai < 2; ++ai)
#pragma unroll
            for (int m = 0; m < 4; ++m) { float s = 0.f;
#pragma unroll
                for (int bj = 0; bj < 2; ++bj)
#pragma unroll
                    for (int n = 0; n < 2; ++n) { const f32x4 x = v[ai][bj][m][n]; s += (x[0] * x[0] + x[1] * x[1]) + (x[2] * x[2] + x[3] * x[3]); }
                s += __shfl_xor(s, 16); s += __shfl_xor(s, 32);
                if (fq == 0) Pt[(ai * HALF + wr * 64 + m * 16 + fr) * 4 + wc] = s; }
        asm volatile("s_waitcnt lgkmcnt(0)" ::: "memory"); __builtin_amdgcn_s_barrier(); asm volatile("" ::: "memory");
        const int row = wid * 32 + (lane & 31);
        if (lane < 32) { const float tot = (Pt[row * 4 + 0] + Pt[row * 4 + 1]) + (Pt[row * 4 + 2] + Pt[row * 4 + 3]);
            __hip_atomic_store(slots + ((size_t)(u.pm * BM + row) * 8 + u.pn), tot, __ATOMIC_RELAXED, __HIP_MEMORY_SCOPE_AGENT); }
        asm volatile("s_waitcnt vmcnt(0)" ::: "memory");
        if (lane == 0) __hip_atomic_fetch_add(cnt + 64 * u.pm, 1u, __ATOMIC_RELAXED, __HIP_MEMORY_SCOPE_AGENT);
        if (wid == 0) {
            unsigned sp = 0;
            while ((unsigned)__builtin_amdgcn_readfirstlane(__hip_atomic_load(cnt + 64 * u.pm, __ATOMIC_RELAXED, __HIP_MEMORY_SCOPE_AGENT)) < 64u) { __builtin_amdgcn_s_sleep(2); if (++sp > (1u << 22)) break; }
            __builtin_amdgcn_fence(__ATOMIC_ACQUIRE, "agent");
        }
        asm volatile("s_waitcnt vmcnt(0) lgkmcnt(0)" ::: "memory"); __builtin_amdgcn_s_barrier(); asm volatile("" ::: "memory");
        if (lane < 32) { const float* sl = slots + (size_t)(u.pm * BM + row) * 8; f32x4 sa, sb;
            asm volatile("global_load_dwordx4 %0, %2, off sc1\n\tglobal_load_dwordx4 %1, %2, off offset:16 sc1\n\ts_waitcnt vmcnt(0)" : "=&v"(sa), "=&v"(sb) : "v"(sl) : "memory");
            St[row] = ((sa.x + sa.y) + (sa.z + sa.w)) + ((sb.x + sb.y) + (sb.z + sb.w)); }
        asm volatile("s_waitcnt lgkmcnt(0)" ::: "memory"); __builtin_amdgcn_s_barrier(); asm volatile("" ::: "memory");
    }
};
struct EpiX1H2 {
    static constexpr bool PERM = true, FUSED = true, HAS_MID = true;
    const float* par; half_t* x1h; half_t* h2; PanelXchg x1, x2;
    const float* ssa; const float* ssr;
    __device__ __forceinline__ void unit_begin(const Unit& u, LAS unsigned char* tab) const {
        const int l = lane_id();
        LAS float* T1 = (LAS float*)(tab + 6144); LAS float* T2 = (LAS float*)(tab + 7168);
#pragma unroll
        for (int k = 0; k < 4; ++k) { const int r = k * 64 + l; const size_t row = (size_t)u.pm * BM + r;
            const float ra = 1.0f / sqrtf(ssa[row] * (1.0f / 1024.0f) + EPS), rr = 1.0f / sqrtf(ssr[row] * (1.0f / 1024.0f) + EPS);
            T1[r] = ra / rr; T2[r] = rr; }
        asm volatile("s_waitcnt lgkmcnt(0)" ::: "memory");
    }
    __device__ __forceinline__ void mid(f32x4 (&acc)[2][2][4][2], int wr, LAS unsigned char* tab) const {
        const LAS float* T1 = (const LAS float*)(tab + 6144); const int fr = lane_id() & 15;
#pragma unroll
        for (int ai = 0; ai < 2; ++ai)
#pragma unroll
            for (int m = 0; m < 4; ++m) { const float s = T1[ai * HALF + wr * 64 + m * 16 + fr];
#pragma unroll
                for (int bj = 0; bj < 2; ++bj)
#pragma unroll
                    for (int n = 0; n < 2; ++n) acc[ai][bj][m][n] *= s; }
        asm volatile("s_waitcnt lgkmcnt(0)" ::: "memory");
    }
    __device__ __forceinline__ void fused(f32x4 (&acc)[2][2][4][2], const Unit& u, int wr, int wc, int fr_, int fq_, LAS unsigned char* tab, int wid, int lane_) const {
        const int lane = lane_id(), fr = lane & 15, fq = lane >> 4;
        const LAS float* St = (const LAS float*)(tab + 4096);
        const int rl0 = wr * 64 + fr, b = u.pm >> 3, col0 = u.pn * BM + wc * 32 + 8 * fq;
        const unsigned eoff0 = (unsigned)(u.pm * BM + rl0) * DM + col0;
        const char* xb = (const char*)x1h;
        half8 xp[2][4][2];
#pragma unroll
        for (int ai = 0; ai < 2; ++ai)
#pragma unroll
            for (int m = 0; m < 4; ++m)
#pragma unroll
                for (int bj = 0; bj < 2; ++bj) xp[ai][m][bj] = __builtin_nontemporal_load((const half8*)(xb + (size_t)((eoff0 + (unsigned)((ai * HALF + m * 16) * DM + bj * HALF)) * 2u)));
        x1.run(acc, u, wr, wc, fr, fq, tab, wid, lane);
        float rs[2][4];
        { const LAS float* T2 = (const LAS float*)(tab + 7168);
#pragma unroll
          for (int ai = 0; ai < 2; ++ai)
#pragma unroll
            for (int m = 0; m < 4; ++m) { const float t2 = T2[rl0 + ai * HALF + m * 16]; rs[ai][m] = t2 / sqrtf(t2 * t2 * St[rl0 + ai * HALF + m * 16] * (1.0f / DM) + EPS); } }
#pragma unroll
        for (int bj = 0; bj < 2; ++bj) { const int c = col0 + bj * HALF;
            const f32x4 a0 = *(const f32x4*)(par + (size_t)(0 * 8 + b) * DM + c), a1 = *(const f32x4*)(par + (size_t)(0 * 8 + b) * DM + c + 4);
#pragma unroll
            for (int ai = 0; ai < 2; ++ai)
#pragma unroll
                for (int m = 0; m < 4; ++m) { const half8 xh = xp[ai][m][bj];
                    const f32x4 x0 = {(float)xh[0], (float)xh[1], (float)xh[2], (float)xh[3]}, x1v = {(float)xh[4], (float)xh[5], (float)xh[6], (float)xh[7]};
                    acc[ai][bj][m][0] = x0 + a0 * (acc[ai][bj][m][0] * rs[ai][m]); acc[ai][bj][m][1] = x1v + a1 * (acc[ai][bj][m][1] * rs[ai][m]); } }
        x2.run(acc, u, wr, wc, fr, fq, tab, wid, lane);
        unsigned eoffS = eoff0; asm volatile("" : "+v"(eoffS));
#pragma unroll
        for (int ai = 0; ai < 2; ++ai)
#pragma unroll
            for (int m = 0; m < 4; ++m) rs[ai][m] = 1.0f / sqrtf(St[rl0 + ai * HALF + m * 16] * (1.0f / DM) + EPS);
#pragma unroll
        for (int bj = 0; bj < 2; ++bj) { const int c = col0 + bj * HALF;
            const f32x4 g0 = *(const f32x4*)(par + (size_t)(1 * 8 + b) * DM + c), g1 = *(const f32x4*)(par + (size_t)(1 * 8 + b) * DM + c + 4);
            const f32x4 s0 = *(const f32x4*)(par + (size_t)(2 * 8 + b) * DM + c), s1 = *(const f32x4*)(par + (size_t)(2 * 8 + b) * DM + c + 4);
#pragma unroll
            for (int ai = 0; ai < 2; ++ai)
#pragma unroll
                for (int m = 0; m < 4; ++m) { const unsigned boff = (eoffS + (unsigned)((ai * HALF + m * 16) * DM + bj * HALF)) * 2u;
                    const f32x4 v0 = acc[ai][bj][m][0], v1 = acc[ai][bj][m][1];
                    u32x4 w; w.x = pk2h(v0[0], v0[1]); w.y = pk2h(v0[2], v0[3]); w.z = pk2h(v1[0], v1[1]); w.w = pk2h(v1[2], v1[3]);
                    __builtin_nontemporal_store(w, (u32x4*)((char*)x1h + (size_t)boff));
                    const f32x4 h0 = v0 * rs[ai][m] * g0 + s0, h1 = v1 * rs[ai][m] * g1 + s1;
                    u32x4 q; q.x = pk2x<FFN_DT>(h0[0], h0[1]); q.y = pk2x<FFN_DT>(h0[2], h0[3]); q.z = pk2x<FFN_DT>(h1[0], h1[1]); q.w = pk2x<FFN_DT>(h1[2], h1[3]);
                    *(u32x4*)((char*)h2 + (size_t)boff) = q; } }
    }
};
struct EpiFinal {
    static constexpr bool PERM = true, FUSED = true;
    const half_t* x1h; const float* par; float* out; PanelXchg xs;
    __device__ __forceinline__ void fused(f32x4 (&acc)[2][2][4][2], const Unit& u, int wr, int wc, int fr_, int fq_, LAS unsigned char* tab, int wid, int lane_) const {
        const int lane = lane_id(), fr = lane & 15, fq = lane >> 4;
        const LAS float* St = (const LAS float*)(tab + 4096);
        const int rl0 = wr * 64 + fr, b = u.pm >> 3, col0 = u.pn * BM + wc * 32 + 8 * fq;
        const unsigned eoff0 = (unsigned)(u.pm * BM + rl0) * DM + col0;
        const char* xb = (const char*)x1h;
        half8 xp[2][4][2];
#pragma unroll
        for (int ai = 0; ai < 2; ++ai)
#pragma unroll
            for (int m = 0; m < 4; ++m)
#pragma unroll
                for (int bj = 0; bj < 2; ++bj) xp[ai][m][bj] = __builtin_nontemporal_load((const half8*)(xb + (size_t)((eoff0 + (unsigned)((ai * HALF + m * 16) * DM + bj * HALF)) * 2u)));
        xs.run(acc, u, wr, wc, fr, fq, tab, wid, lane);
        unsigned eoffS = eoff0; asm volatile("" : "+v"(eoffS));
        float rs[2][4];
#pragma unroll
        for (int ai = 0; ai < 2; ++ai)
#pragma unroll
            for (int m = 0; m < 4; ++m) rs[ai][m] = 1.0f / sqrtf(St[rl0 + ai * HALF + m * 16] * (1.0f / DM) + EPS);
#pragma unroll
        for (int bj = 0; bj < 2; ++bj) { const int c = col0 + bj * HALF;
            const f32x4 a0 = *(const f32x4*)(par + (size_t)(3 * 8 + b) * DM + c), a1 = *(const f32x4*)(par + (size_t)(3 * 8 + b) * DM + c + 4);
#pragma unroll
            for (int ai = 0; ai < 2; ++ai)
#pragma unroll
                for (int m = 0; m < 4; ++m) { const unsigned boff = (eoffS + (unsigned)((ai * HALF + m * 16) * DM + bj * HALF)) * 4u; const half8 xh = xp[ai][m][bj];
                    const f32x4 x0 = {(float)xh[0], (float)xh[1], (float)xh[2], (float)xh[3]}, x1v = {(float)xh[4], (float)xh[5], (float)xh[6], (float)xh[7]};
                    *(f32x4*)((char*)out + (size_t)boff) = x0 + a0 * (acc[ai][bj][m][0] * rs[ai][m]); *(f32x4*)((char*)out + (size_t)boff + 16) = x1v + a1 * (acc[ai][bj][m][1] * rs[ai][m]); } }
    }
};

struct ProjOrder : StaticOrder {
    unsigned* cnt;
    int wv;
    __device__ __forceinline__ void done(int ui) const {
        if (ui == 3) { asm volatile("s_waitcnt vmcnt(0)" ::: "memory");
            __builtin_amdgcn_s_barrier();
            if (wv == 0 && lane_id() == 0) { __builtin_amdgcn_fence(__ATOMIC_RELEASE, "agent"); asm volatile("s_waitcnt vmcnt(0)" ::: "memory");
                __hip_atomic_fetch_add(cnt + 64 * (c & 7), 1u, __ATOMIC_RELAXED, __HIP_MEMORY_SCOPE_AGENT); } }
    }
};
template <class S> struct has_done { template <class T> static constexpr bool test(decltype(&T::done)) { return true; } template <class T> static constexpr bool test(...) { return false; } static constexpr bool value = test<S>(nullptr); };
struct ListOrder {
    int first, n, pm0, npn;
    __device__ bool next(int i, Unit& u) const { if (i >= n) return false; const int idx = first + i; u.pm = pm0 + idx / npn; u.pn = idx % npn; return true; }
};
template <class E> struct has_mid { template <class T> static constexpr bool test(decltype(T::HAS_MID)*) { return true; } template <class T> static constexpr bool test(...) { return false; } static constexpr bool value = test<E>(nullptr); };
template <class E> struct is_fused { template <class T> static constexpr bool test(decltype(T::FUSED)*) { return true; } template <class T> static constexpr bool test(...) { return false; } static constexpr bool value = test<E>(nullptr); };

template <class Geo, class Epi, class Sched, bool ALIGN_EPI, bool SP2, int DT = 0, int NTA = 0>
__device__ __forceinline__ void gemm_phase(LAS unsigned char* lds, const Geo g, const Sched& S, const Epi& E, int wv) {
    const int tid = make_tid(wv), wid = __builtin_amdgcn_readfirstlane(tid >> 6), lane = tid & 63, wr = wid >> 2, wc = wid & 3, fr = lane & 15, fq = lane >> 4;
    const int nt = g.nt(); const int ldb = g.ldb();
    unsigned voffA, voffB;
    { int R, C; stage_rc(tid * 16, R, C); const int Rb = Epi::PERM ? ((R & ~31) + perm32(R & 31)) : R; voffA = g.voffA(R, C); voffB = (unsigned)(Rb * ldb + C) * 2u; }
    const size_t dA64 = (size_t)(g.voffA(64, 0) - g.voffA(0, 0)), dB64 = (size_t)64 * ldb * 2;
    const size_t kstepA = g.kstepA(), kstepB = (size_t)(BK * 2);
    const size_t hstepA = g.hstepA(), hstepB = (size_t)HALF * ldb * 2;
    const unsigned ldsw = (unsigned)wid * 1024u;
    const int aoff = lds_byte(wr * 64 + fr, fq * 8), boff = lds_byte(wc * 32 + fr, fq * 8);
#define PG8_SA(b, h) (((b) * 2 + (h)) * HTB)
#define PG8_SB(b, h) ((4 + (b) * 2 + (h)) * HTB)
#define PG8_STAGE(bufoff, gbase, voff) do { \
        __builtin_amdgcn_global_load_lds((const unsigned*)((const char*)(gbase) + (voff)), (LAS unsigned*)(lds + (bufoff) + ldsw), 16, 0, aux_##voff); \
        __builtin_amdgcn_global_load_lds((const unsigned*)((const char*)(gbase) + d64_##voff + (voff)), (LAS unsigned*)(lds + (bufoff) + ldsw + 8192), 16, 0, aux_##voff); } while (0)
    const size_t d64_voffA = dA64, d64_voffB = dB64;
    constexpr int aux_voffA = NTA ? 2 : 0, aux_voffB = 0;
#define PG8_LDA(dst, b, h) do { _Pragma("unroll") for (int m = 0; m < 4; ++m) _Pragma("unroll") for (int k = 0; k < 2; ++k) dst[m][k] = *(const LAS half8*)(lds + PG8_SA(b, h) + aoff + m * 2048 + k * 1024); } while (0)
#define PG8_LDB(dst, b, h) do { _Pragma("unroll") for (int n = 0; n < 2; ++n) _Pragma("unroll") for (int k = 0; k < 2; ++k) dst[n][k] = *(const LAS half8*)(lds + PG8_SB(b, h) + boff + n * 2048 + k * 1024); } while (0)
#define PG8_MMA(ai, bj, At, Bt) do { __builtin_amdgcn_s_setprio(1); _Pragma("unroll") for (int m = 0; m < 4; ++m) _Pragma("unroll") for (int n = 0; n < 2; ++n) _Pragma("unroll") for (int k = 0; k < 2; ++k) \
        acc[ai][bj][m][n] = DT ? __builtin_amdgcn_mfma_f32_16x16x32_bf16(__builtin_bit_cast(bf16x8, Bt[n][k]), __builtin_bit_cast(bf16x8, At[m][k]), acc[ai][bj][m][n], 0, 0, 0) \
                               : __builtin_amdgcn_mfma_f32_16x16x32_f16(Bt[n][k], At[m][k], acc[ai][bj][m][n], 0, 0, 0); __builtin_amdgcn_s_setprio(0); } while (0)
#define PG8_WAIT_V(n) asm volatile("s_waitcnt vmcnt(" #n ")" ::: "memory")
#define PG8_WAIT_L(n) asm volatile("s_waitcnt lgkmcnt(" #n ")" ::: "memory")
#define PG8_BAR __builtin_amdgcn_s_barrier()
#define PG8_SCHED __builtin_amdgcn_sched_barrier(0)
    Unit cur, nxt; int ui = 0;
    if (!S.next(0, cur)) return;
    f32x4 acc[2][2][4][2];
#pragma unroll
    for (int a = 0; a < 2; ++a)
#pragma unroll
        for (int b = 0; b < 2; ++b)
#pragma unroll
            for (int m = 0; m < 4; ++m)
#pragma unroll
                for (int n = 0; n < 2; ++n) acc[a][b][m][n] = (f32x4){0.f, 0.f, 0.f, 0.f};
    half8 At[4][2], B0[2][2], B1[2][2];
    const char* cA = g.a_base(cur); const char* cB = g.b_base(cur);
    if constexpr (has_mid<Epi>::value) E.unit_begin(cur, lds + XTAB_OFF);
    if constexpr (SP2) {
        PG8_STAGE(PG8_SB(0, 0), cB, voffB); PG8_STAGE(PG8_SB(0, 1), cB + hstepB, voffB); PG8_STAGE(PG8_SA(0, 0), cA, voffA); PG8_STAGE(PG8_SA(0, 1), cA + hstepA, voffA);
        if (wr == 1) PG8_BAR;
        PG8_WAIT_V(2); PG8_BAR;
        PG8_STAGE(PG8_SB(1, 0), cB + kstepB, voffB); PG8_STAGE(PG8_SA(1, 0), cA + kstepA, voffA); PG8_STAGE(PG8_SB(1, 1), cB + hstepB + kstepB, voffB);
        PG8_WAIT_V(6); PG8_BAR;
    } else {
        PG8_STAGE(PG8_SB(0, 0), cB, voffB); PG8_STAGE(PG8_SA(0, 0), cA, voffA); PG8_STAGE(PG8_SB(0, 1), cB + hstepB, voffB); PG8_STAGE(PG8_SA(0, 1), cA + hstepA, voffA);
        if (wr == 1) PG8_BAR;
        PG8_WAIT_V(4); PG8_BAR;
        PG8_STAGE(PG8_SB(1, 0), cB + kstepB, voffB); PG8_STAGE(PG8_SA(1, 0), cA + kstepA, voffA); PG8_STAGE(PG8_SB(1, 1), cB + hstepB + kstepB, voffB);
        PG8_WAIT_V(6); PG8_BAR;
    }
    for (;;) {
        const bool has_next = S.next(ui + 1, nxt);
        const char* nA = has_next ? g.a_base(nxt) : cA; const char* nB = has_next ? g.b_base(nxt) : cB;
        for (int t = 0; t < nt; t += 2) {
            if constexpr (has_mid<Epi>::value) { if (t == nt / 2) E.mid(acc, wr, lds + XTAB_OFF); }
            const bool last = (t == nt - 2);
            const char* a1 = cA + (size_t)(t + 1) * kstepA;
            const char* a2 = last ? nA : cA + (size_t)(t + 2) * kstepA; const char* b2 = last ? nB : cB + (size_t)(t + 2) * kstepB;
            const char* a3 = a2 + kstepA; const char* b3 = b2 + kstepB;
            if constexpr (SP2) {
            PG8_LDB(B0, 0, 0); PG8_LDB(B1, 0, 1); PG8_SCHED; PG8_LDA(At, 0, 0); PG8_STAGE(PG8_SA(1, 1), a1 + hstepA, voffA);
            PG8_WAIT_V(8); PG8_WAIT_L(0); PG8_BAR; PG8_MMA(0, 0, At, B0); PG8_MMA(0, 1, At, B1); PG8_BAR; PG8_SCHED;
            PG8_LDA(At, 0, 1); PG8_STAGE(PG8_SB(0, 0), b2, voffB); PG8_STAGE(PG8_SB(0, 1), b2 + hstepB, voffB); PG8_STAGE(PG8_SA(0, 0), a2, voffA);
            PG8_WAIT_V(8); PG8_WAIT_L(0); PG8_BAR; PG8_MMA(1, 0, At, B0); PG8_MMA(1, 1, At, B1); PG8_BAR; PG8_SCHED;
            PG8_LDB(B0, 1, 0); PG8_LDB(B1, 1, 1); PG8_SCHED; PG8_LDA(At, 1, 0); PG8_STAGE(PG8_SA(0, 1), a2 + hstepA, voffA);
            PG8_WAIT_V(8); PG8_WAIT_L(0); PG8_BAR; PG8_MMA(0, 0, At, B0); PG8_MMA(0, 1, At, B1); PG8_BAR; PG8_SCHED;
            PG8_LDA(At, 1, 1); PG8_STAGE(PG8_SB(1, 0), b3, voffB); PG8_STAGE(PG8_SB(1, 1), b3 + hstepB, voffB); PG8_STAGE(PG8_SA(1, 0), a3, voffA);
            PG8_WAIT_V(8); PG8_WAIT_L(0); PG8_BAR; PG8_MMA(1, 0, At, B0); PG8_MMA(1, 1, At, B1); PG8_BAR; PG8_SCHED;
            } else {
            PG8_LDB(B0, 0, 0); PG8_SCHED; PG8_LDA(At, 0, 0); PG8_STAGE(PG8_SA(1, 1), a1 + hstepA, voffA);
            PG8_WAIT_L(8); PG8_BAR; PG8_WAIT_L(0); PG8_MMA(0, 0, At, B0); PG8_BAR; PG8_SCHED;
            PG8_LDB(B1, 0, 1); PG8_STAGE(PG8_SB(0, 0), b2, voffB);
            PG8_BAR; PG8_WAIT_L(0); PG8_MMA(0, 1, At, B1); PG8_BAR;
            PG8_LDA(At, 0, 1); PG8_STAGE(PG8_SA(0, 0), a2, voffA);
            PG8_BAR; PG8_WAIT_L(0); PG8_MMA(1, 0, At, B0); PG8_BAR; PG8_SCHED;
            PG8_STAGE(PG8_SB(0, 1), b2 + hstepB, voffB);
            PG8_WAIT_V(6); PG8_BAR; PG8_MMA(1, 1, At, B1); PG8_BAR;
            PG8_LDB(B0, 1, 0); PG8_SCHED; PG8_LDA(At, 1, 0); PG8_STAGE(PG8_SA(0, 1), a2 + hstepA, voffA);
            PG8_WAIT_L(8); PG8_BAR; PG8_WAIT_L(0); PG8_MMA(0, 0, At, B0); PG8_BAR; PG8_SCHED;
            PG8_LDB(B1, 1, 1); PG8_STAGE(PG8_SB(1, 0), b3, voffB);
            PG8_BAR; PG8_WAIT_L(0); PG8_MMA(0, 1, At, B1); PG8_BAR;
            PG8_LDA(At, 1, 1); PG8_STAGE(PG8_SA(1, 0), a3, voffA);
            PG8_BAR; PG8_WAIT_L(0); PG8_MMA(1, 0, At, B0); PG8_BAR; PG8_SCHED;
            PG8_STAGE(PG8_SB(1, 1), b3 + hstepB, voffB);
            PG8_WAIT_V(6); PG8_BAR; PG8_MMA(1, 1, At, B1); PG8_BAR;
            }
        }
        if constexpr (ALIGN_EPI) { if (wr == 0) PG8_BAR; }
        if constexpr (is_fused<Epi>::value) E.fused(acc, cur, wr, wc, fr, fq, lds + XTAB_OFF, wid, lane); else E(acc, cur, wr, wc, fr, fq);
        if constexpr (has_done<Sched>::value) S.done(ui);
        if (!has_next) break;
        if constexpr (has_mid<Epi>::value) E.unit_begin(nxt, lds + XTAB_OFF);
#pragma unroll
        for (int a = 0; a < 2; ++a)
#pragma unroll
            for (int b = 0; b < 2; ++b)
#pragma unroll
                for (int m = 0; m < 4; ++m)
#pragma unroll
                    for (int n = 0; n < 2; ++n) acc[a][b][m][n] = (f32x4){0.f, 0.f, 0.f, 0.f};
        cur = nxt; cA = nA; cB = nB; ++ui;
        if constexpr (ALIGN_EPI) { if (wr == 1) PG8_BAR; }
    }
    PG8_WAIT_V(0);
    if constexpr (!ALIGN_EPI) { if (wr == 0) PG8_BAR; }
    PG8_BAR;
#undef PG8_SA
#undef PG8_SB
#undef PG8_STAGE
#undef PG8_LDA
#undef PG8_LDB
#undef PG8_MMA
#undef PG8_WAIT_V
#undef PG8_WAIT_L
#undef PG8_BAR
#undef PG8_SCHED
}
}

#define XB_TMO      128
#define XB_XCNT(j)  (256  + 64 * (j))
#define XB_XSUB(j)  (1280 + 64 * (j))
#define XB_XGEN(j)  (2304 + 64 * (j))
#define XB_TOP      3328
#define XB_TOPGEN   3392
#define XCD_BAR_WORDS 3456
#define XB_SPIN_CAP (1u << 22)
__device__ __forceinline__ unsigned xb_ld(unsigned* p)              { return __hip_atomic_load(p, __ATOMIC_RELAXED, __HIP_MEMORY_SCOPE_AGENT); }
__device__ __forceinline__ unsigned xb_add(unsigned* p, unsigned v) { return __hip_atomic_fetch_add(p, v, __ATOMIC_RELAXED, __HIP_MEMORY_SCOPE_AGENT); }
__device__ __forceinline__ unsigned xb_xcc_id() { return (unsigned)__builtin_amdgcn_s_getreg((3 << 11) | 20) & 0xFu; }
#define XB_SPIN(cond, bar) do { unsigned _sp = 0; while (cond) { __builtin_amdgcn_s_sleep(1); \
    if ((++_sp & 255u) == 0u) { if (xb_ld(&(bar)[XB_TMO])) break; if (_sp > XB_SPIN_CAP) { atomicAdd(&(bar)[XB_TMO], 1u); break; } } } } while (0)
struct XcdBarrier { unsigned* bar; unsigned x; volatile LAS unsigned* st; int wv; };
__device__ __forceinline__ XcdBarrier xcd_barrier_post(unsigned* bar, volatile LAS unsigned* st, int wv) {
    XcdBarrier b; b.bar = bar; b.x = xb_xcc_id(); b.st = st; b.wv = wv;
    if (wv == 0 && lane_id() == 0) (void)xb_add(&bar[XB_XCNT(b.x)], 1u);
    return b;
}
__device__ __forceinline__ void xcd_barrier_complete(unsigned* bar, unsigned x, unsigned& nloc, unsigned& nx) {
    const unsigned G = gridDim.x * gridDim.y * gridDim.z;
    unsigned sum, cnt, mine, sp = 0u;
    for (;;) {
        sum = 0u; cnt = 0u; mine = 0u;
#pragma unroll
        for (unsigned j = 0; j < 16; ++j) { const unsigned c = xb_ld(&bar[XB_XCNT(j)]); sum += c; cnt += (c > 0u) ? 1u : 0u; mine = (j == x) ? c : mine; }
        if (sum == G) break;
        __builtin_amdgcn_s_sleep(1);
        if ((++sp & 255u) == 0u) { if (xb_ld(&bar[XB_TMO])) break; if (sp > XB_SPIN_CAP) { atomicAdd(&bar[XB_TMO], 1u); break; } }
    }
    nloc = mine > 0u ? mine : 1u; nx = cnt > 0u ? cnt : 1u;
}
__device__ __forceinline__ void xcd_barrier(const XcdBarrier& b) {
    asm volatile("s_waitcnt vmcnt(0)" ::: "memory");
    __syncthreads();
    if (b.wv == 0 && lane_id() == 0) {
        unsigned* bar = b.bar;
        __builtin_amdgcn_s_waitcnt(0);
        unsigned nloc = b.st[0], nx = b.st[1];
        if (nloc == 0u) { xcd_barrier_complete(bar, b.x, nloc, nx); b.st[0] = nloc; b.st[1] = nx; }
        const unsigned old = xb_add(&bar[XB_XSUB(b.x)], 1u);
        const unsigned gen = old / nloc;
        if (old + 1u == (gen + 1u) * nloc) {
            __builtin_amdgcn_fence(__ATOMIC_RELEASE, "agent");
            asm volatile("s_waitcnt vmcnt(0)" ::: "memory");
            const unsigned og = xb_add(&bar[XB_TOP], 1u);
            const unsigned tg = og / nx;
            if (og + 1u == (tg + 1u) * nx) xb_add(&bar[XB_TOPGEN], 1u);
            else XB_SPIN(xb_ld(&bar[XB_TOPGEN]) == tg, bar);
            __builtin_amdgcn_fence(__ATOMIC_ACQUIRE, "agent");
            xb_add(&bar[XB_XGEN(b.x)], 1u);
            asm volatile("s_waitcnt vmcnt(0)" ::: "memory");
        } else {
            XB_SPIN(xb_ld(&bar[XB_XGEN(b.x)]) == gen, bar);
            __builtin_amdgcn_fence(__ATOMIC_ACQUIRE, "agent");
            asm volatile("s_waitcnt vmcnt(0)" ::: "memory");
        }
    }
    __syncthreads();
}

constexpr int NWAVES = 8;
constexpr int RING_BYTES = 131072;
constexpr int LDSCTL_OFF = RING_BYTES, MISC_OFF = LDSCTL_OFF + 320;
constexpr int LDS_BYTES = 147456;

struct Args { const float* in[27]; float* out; unsigned char* ws; int ph_lo, ph_hi; };
typedef const __attribute__((address_space(4))) Args* ArgsP;
__device__ __forceinline__ ArgsP get_args() { ArgsP p = (ArgsP)__builtin_amdgcn_kernarg_segment_ptr(); asm volatile("" : "+s"(p)); return p; }

enum { I_X = 0, I_C, I_WADA, I_BADA, I_GPREMIX, I_GPOSTMIX, I_GPREMLP, I_GPOSTMLP, I_WIN, I_C1K, I_C2K, I_PEK, I_C1V, I_C2V, I_PEV,
       I_CONVW, I_CONVB, I_WRGA, I_BRGA, I_WRGX, I_BRGX, I_LAM, I_GATT, I_GRNN, I_WOUT, I_WFF1, I_WFF2 };

struct Frame {
    LAS unsigned char* lds;
    unsigned char* ws;
    int vcu, G, wv;
};
struct Ids { int tid, lane, wave; };
__device__ __forceinline__ Ids get_ids(int wv) { Ids r; r.tid = make_tid(wv); r.lane = r.tid & 63; r.wave = wv; return r; }

typedef short v4i16_t __attribute__((ext_vector_type(4)));
template <int DT = 0, int PMODE = 0>
__device__ __forceinline__ void transpose_item(const float* W, int ldw, int k0, int srccol, half_t* dst  , int ldk, LAS unsigned char* scr, int lane) {
    const int g = lane >> 4, p = lane & 15;
    f32x4 v[16];
#pragma unroll
    for (int i = 0; i < 16; ++i) v[i] = (srccol >= 0 && PMODE != 2) ? __builtin_nontemporal_load((const f32x4*)(W + (size_t)(k0 + 16 * g + i) * ldw + srccol)) : (f32x4){0.f, 0.f, 0.f, 0.f};
#pragma unroll
    for (int j = 0; j < 4; ++j) {
        const int n = 4 * p + j;
        LAS unsigned char* wr = scr + n * 128;
#pragma unroll
        for (int h = 0; h < 2; ++h) {
            u32x4 o; o.x = pk2x<DT>(v[8 * h + 0][j], v[8 * h + 1][j]); o.y = pk2x<DT>(v[8 * h + 2][j], v[8 * h + 3][j]); o.z = pk2x<DT>(v[8 * h + 4][j], v[8 * h + 5][j]); o.w = pk2x<DT>(v[8 * h + 6][j], v[8 * h + 7][j]);
            *(LAS u32x4*)(wr + (((2 * g + h) ^ (p & 7)) * 16)) = o;
        }
    }
    LDS_WAIT(); asm volatile("" ::: "memory");
    const int kc = lane & 7;
#pragma unroll
    for (int jj = 0; jj < 8; ++jj) {
        const int n = 8 * jj + (lane >> 3);
        const u32x4 o = *(const LAS u32x4*)(scr + n * 128 + ((kc ^ ((n >> 2) & 7)) * 16));
        if (PMODE != 3) *(u32x4*)(dst + (size_t)n * ldk + 8 * kc) = o; else asm volatile("" :: "v"(o));
    }
    LDS_WAIT(); asm volatile("" ::: "memory");
}

__device__ __forceinline__ void p0_prologue(Frame& F, int rep) {
    ArgsP ap = get_args();
    const Ids I = get_ids(F.wv);
    unsigned char* ws = F.ws;
    __syncthreads();
    {
        LAS float* cact = (LAS float*)F.lds;
        LAS float* part = (LAS float*)(F.lds + 65536);
        const float* c = ap->in[I_C];
        for (int i = I.tid; i < NB * DM; i += 512) cact[(i % DM) * 8 + i / DM] = siluf_(c[i]);
        __syncthreads();
        const float* wada = ap->in[I_WADA]; float* mod = (float*)(ws + WS_MOD);
        for (int cv = F.vcu; cv < 256; cv += F.G) {
        const int col0 = 48 * cv, cq = I.tid % 12, ro = I.tid / 12;
        if (ro < 42) {
            f32x4 acc[8];
#pragma unroll
            for (int b = 0; b < 8; ++b) acc[b] = (f32x4){0.f, 0.f, 0.f, 0.f};
            const float* wp = wada + (size_t)ro * 12288 + col0 + 4 * cq;
            f32x4 w4[2][8];
#pragma unroll
            for (int u = 0; u < 8; ++u) w4[0][u] = __builtin_nontemporal_load((const f32x4*)(wp + (size_t)u * 42 * 12288));
            __builtin_amdgcn_sched_barrier(0);
#pragma unroll
            for (int jq = 0; jq < 6; ++jq) { const int jb = 8 * jq;
                if (jq + 1 < 6) {
#pragma unroll
                    for (int u = 0; u < 8; ++u) w4[(jq + 1) & 1][u] = __builtin_nontemporal_load((const f32x4*)(wp + (size_t)(jb + 8 + u) * 42 * 12288)); }
                __builtin_amdgcn_sched_barrier(0);
#pragma unroll
                for (int u = 0; u < 8; ++u) { const int k = ro + 42 * (jb + u); const f32x4 c0 = *(const LAS f32x4*)(cact + k * 8), c1 = *(const LAS f32x4*)(cact + k * 8 + 4); const f32x4 wv = w4[jq & 1][u];
                    acc[0] += wv * c0.x; acc[1] += wv * c0.y; acc[2] += wv * c0.z; acc[3] += wv * c0.w; acc[4] += wv * c1.x; acc[5] += wv * c1.y; acc[6] += wv * c1.z; acc[7] += wv * c1.w; }
                __builtin_amdgcn_sched_barrier(0);
            }
            { const int k = ro + 42 * 48; if (k < DM) { const f32x4 w4 = *(const f32x4*)(wp + (size_t)48 * 42 * 12288);
#pragma unroll
                for (int b = 0; b < 8; ++b) acc[b] += w4 * cact[k * 8 + b]; } }
#pragma unroll
            for (int b = 0; b < 8; ++b) *(LAS f32x4*)(part + (ro * 8 + b) * 48 + 4 * cq) = acc[b];
        }
        __syncthreads();
        if (I.tid < 384) { const int b = I.tid / 48, cc = I.tid % 48; float s = ap->in[I_BADA][col0 + cc];
            for (int r = 0; r < 42; ++r) s += part[(r * 8 + b) * 48 + cc];
            mod[b * 12288 + col0 + cc] = s; }
        __syncthreads();
        }
    }
    if (rep == 0) for (int bv = (F.G == 256) ? (((F.vcu & 31) < 4) ? (F.vcu >> 5) * 4 + (F.vcu & 31) : 32) : F.vcu; bv < 32; bv += F.G) {
        const int m = bv >> 4, ks = bv & 15, col = I.tid & 255, hf = I.tid >> 8;
        const float* pe = ap->in[m ? I_PEV : I_PEK]; const float* w1 = ap->in[m ? I_C1V : I_C1K];
        float acc = 0.f; const int kb = 128 * ks + 64 * hf;
#pragma unroll 16
        for (int k = kb; k < kb + 64; ++k) acc += pe[k] * w1[(size_t)k * 256 + col];
        atomicAdd((float*)(ws + WS_CTL) + CW_BIAS1 + m * 256 + col, acc);
    }
    if (F.vcu == 32 || F.G <= 32) { for (int i = I.tid; i < 1024; i += 512) ((float*)(ws + WS_SP8))[i] = 8.0f * log1pf(expf(-ap->in[I_LAM][i])); }
    LAS unsigned char* scr = F.lds + I.wave * 16384;
    const int gw = F.vcu * NWAVES + I.wave, NGW = F.G * NWAVES;
    constexpr int IT_IN = 32 * (NP / 64), IT_OUT = 32 * 32, IT_FF1 = 32 * 128, IT_FF2 = 128 * 32, IT_C1 = 32 * 4, IT_RG = 8 * 2 * 4;
    constexpr int NITEMS = IT_IN + IT_OUT + IT_FF1 + IT_FF2 + 2 * IT_C1 + IT_RG;
    half_t* Wt_in = (half_t*)(ws + WS_WIN); half_t* Wt_out = (half_t*)(ws + WS_WOUT); half_t* Wt_ff1 = (half_t*)(ws + WS_WFF1); half_t* Wt_ff2 = (half_t*)(ws + WS_WFF2);
    half_t* Wt_c1 = (half_t*)(ws + WS_WC1); half_t* Wt_rg = (half_t*)(ws + WS_WRG);
    const int l4 = 4 * (I.lane & 15);
#if PROBE_TM == 1
#define TM_MAP(r, nblk) const int gi_ = (r) >> 3, sub_ = (r) & 7, kb = (gi_ / ((nblk) / 2)) * 4 + (sub_ >> 1), nb = (gi_ % ((nblk) / 2)) * 2 + (sub_ & 1)
#elif PROBE_TM == 2
#define TM_MAP(r, nblk) const int gi_ = (r) >> 3, sub_ = (r) & 7, kb = (gi_ / (nblk)) * 8 + sub_, nb = gi_ % (nblk)
#else
#define TM_MAP(r, nblk) const int kb = (r) / (nblk), nb = (r) % (nblk)
#endif
    static_assert(NITEMS % 8 == 0, "items split evenly over the 8 XCD queues");
    const int xq = F.vcu >> 5;
    unsigned* icnt = (unsigned*)(ws + WS_CTL) + CW_P0Q + 64 * xq;
    const bool dyn = (F.G == 256);
    for (int it = dyn ? 8 * ((F.vcu & 31) * NWAVES + I.wave) + xq : gw; it < NITEMS; ) {
        unsigned got = 0u; if (dyn && I.lane == 0) got = __hip_atomic_fetch_add(icnt, 1u, __ATOMIC_RELAXED, __HIP_MEMORY_SCOPE_AGENT);
        int r = it;
        if (r < IT_IN) { const int nblk = NP / 64; TM_MAP(r, nblk); const int n = nb * 64 + l4;
            const int sc = n < 2560 ? n : (n < 4608 ? n + 48 : (n < 4656 ? n - 2048 : -1));
            transpose_item<PROJ_DT>(ap->in[I_WIN], NPROJ, 64 * kb, sc, Wt_in + (size_t)(nb * 64) * DM + 64 * kb, DM, scr, I.lane); goto item_done; } r -= IT_IN;
        if (r < IT_OUT) { const int nblk = 32; TM_MAP(r, nblk);
            transpose_item<FFN_DT>(ap->in[I_WOUT], DM, 64 * kb, nb * 64 + l4, Wt_out + (size_t)(nb * 64) * DM + 64 * kb, DM, scr, I.lane); goto item_done; } r -= IT_OUT;
        if (r < IT_FF1) { const int nblk = 128; TM_MAP(r, nblk);
            transpose_item<FFN_DT>(ap->in[I_WFF1], DFF, 64 * kb, nb * 64 + l4, Wt_ff1 + (size_t)(nb * 64) * DM + 64 * kb, DM, scr, I.lane); goto item_done; } r -= IT_FF1;
        if (r < IT_FF2) { const int nblk = 32; TM_MAP(r, nblk);
            transpose_item<FFN_DT>(ap->in[I_WFF2], DM, 64 * kb, nb * 64 + l4, Wt_ff2 + (size_t)(nb * 64) * DFF + 64 * kb, DFF, scr, I.lane); goto item_done; } r -= IT_FF2;
        if (r < 2 * IT_C1) { const int m = r / IT_C1, q = r % IT_C1, nblk = 4; TM_MAP(q, nblk);
            transpose_item(ap->in[m ? I_C1V : I_C1K], 256, 64 * kb, nb * 64 + l4, Wt_c1 + (size_t)(m * 256 + nb * 64) * 2048 + 64 * kb, 2048, scr, I.lane); goto item_done; } r -= 2 * IT_C1;
        {
            const int q = r & 3, gate = (r >> 2) & 1, blk = r >> 3, kb = q >> 1, nb = q & 1;
            const float* W = ap->in[gate ? I_WRGX : I_WRGA] + (size_t)blk * 128 * 128;
            half_t* rowbase = Wt_rg + (size_t)(blk * 256 + gate * 128 + nb * 64) * 128;
            transpose_item(W, 128, 64 * kb, nb * 64 + l4, rowbase + 64 * kb, 128, scr, I.lane);
        }
item_done:
        it = dyn ? 8 * (256 + (int)__builtin_amdgcn_readfirstlane((int)got)) + xq : it + NGW;
    }
#if PROBE_P0X
    for (int it = gw; it < IT_FF1; it += NGW) { const int r = it; const int nblk = 128; TM_MAP(r, nblk);
        transpose_item<FFN_DT, PROBE_P0X - 1>(ap->in[I_WFF1], DFF, 64 * kb, nb * 64 + l4, (half_t*)(ws + WS_H2) + (size_t)(nb * 64) * DM + 64 * kb, DM, scr, I.lane); }
#endif
}

__device__ __forceinline__ void p1_norm(Frame& F) {
    ArgsP ap = get_args();
    const Ids I = get_ids(F.wv);
    const int gw = F.vcu * NWAVES + I.wave, NGW = F.G * NWAVES;
    const float* mod = (const float*)(F.ws + WS_MOD); half_t* hbuf = (half_t*)(F.ws + WS_HBUF); half_t* xh = (half_t*)(F.ws + WS_X1H);
    {
        float* par = (float*)(F.ws + WS_PAR);
        for (int i = F.vcu * 512 + I.tid; i < NB * DM; i += F.G * 512) { const int b = i / DM, c = i % DM; const float* mb = mod + b * 12288;
            par[(0 * 8 + b) * DM + c] = mb[4096 + c] * ap->in[I_GPOSTMIX][c];
            par[(1 * 8 + b) * DM + c] = ap->in[I_GPREMLP][c] * (1.0f + mb[8192 + c]);
            par[(2 * 8 + b) * DM + c] = mb[6144 + c];
            par[(3 * 8 + b) * DM + c] = mb[10240 + c] * ap->in[I_GPOSTMLP][c]; }
    }
    for (int rb = gw; rb < NTOK / 8; rb += NGW) {
        const int row0 = rb * 8, b = row0 / SEQ;
        f32x4 A[8], Bv[8];
#pragma unroll
        for (int j = 0; j < 8; ++j) { const int c = 4 * I.lane + 256 * j; const f32x4 g = *(const f32x4*)(ap->in[I_GPREMIX] + c), sc = *(const f32x4*)(mod + b * 12288 + 2048 + c); A[j] = g * (sc + 1.0f); Bv[j] = *(const f32x4*)(mod + b * 12288 + c); }
        f32x4 va[8], vb[8];
#define P1_LOAD(buf, r) do { const float* xr_ = ap->in[I_X] + (size_t)(row0 + (r)) * DM; _Pragma("unroll") for (int j = 0; j < 8; ++j) buf[j] = __builtin_nontemporal_load((const f32x4*)(xr_ + 4 * I.lane + 256 * j)); __builtin_amdgcn_sched_barrier(0); } while (0)
#define P1_ROW(buf, r) do { float s_ = 0.f; _Pragma("unroll") for (int j = 0; j < 8; ++j) s_ += (buf[j].x * buf[j].x + buf[j].y * buf[j].y) + (buf[j].z * buf[j].z + buf[j].w * buf[j].w); \
            const float rstd = 1.0f / sqrtf(wave_sum(s_) * (1.0f / DM) + EPS); \
            half_t* ho = hbuf + (size_t)(row0 + (r)) * DM; half_t* xo = xh + (size_t)(row0 + (r)) * DM; \
            _Pragma("unroll") for (int j = 0; j < 8; ++j) { const f32x4 y = buf[j] * rstd * A[j] + Bv[j]; u32x2 w; w.x = pk2x<PROJ_DT>(y.x, y.y); w.y = pk2x<PROJ_DT>(y.z, y.w); *(u32x2*)(ho + 4 * I.lane + 256 * j) = w; \
                u32x2 wx; wx.x = pk2h(buf[j].x, buf[j].y); wx.y = pk2h(buf[j].z, buf[j].w); __builtin_nontemporal_store(wx, (u32x2*)(xo + 4 * I.lane + 256 * j)); } \
            __builtin_amdgcn_sched_barrier(0); } while (0)
        P1_LOAD(va, 0);
#pragma unroll
        for (int r = 0; r < 8; r += 2) {
            P1_LOAD(vb, r + 1);
            P1_ROW(va, r);
            if (r + 2 < 8) P1_LOAD(va, r + 2);
            P1_ROW(vb, r + 1);
        }
#undef P1_LOAD
#undef P1_ROW
    }
}

__device__ __forceinline__ void p3_conv(Frame& F, int rb_first, int rb_last, int worker, int nworkers) {
    ArgsP ap = get_args();
    const Ids I = get_ids(F.wv);
    const half_t* P = (const half_t*)(F.ws + WS_P); half_t* xc = (half_t*)(F.ws + WS_XC);
    const float* cw = ap->in[I_CONVW]; const float* cb = ap->in[I_CONVB];
    f32x4 w[2][4][2], bb[2][2];
#pragma unroll
    for (int hh = 0; hh < 2; ++hh) { const int c0 = hh * 512 + 8 * I.lane;
#pragma unroll
        for (int k = 0; k < 4; ++k) { w[hh][k][0] = *(const f32x4*)(cw + k * 1024 + c0); w[hh][k][1] = *(const f32x4*)(cw + k * 1024 + c0 + 4); }
        bb[hh][0] = *(const f32x4*)(cb + c0); bb[hh][1] = *(const f32x4*)(cb + c0 + 4); }
    half8 xa[11], xb[11];
#define P3_LOAD(buf, rbv, hh) do { const int c0_ = (hh) * 512 + 8 * I.lane, row0_ = (rbv) * 8, t0_ = row0_ % SEQ; \
        _Pragma("unroll") for (int i = 0; i < 11; ++i) { const int tt = t0_ - 3 + i; buf[i] = (tt >= 0) ? *(const half8*)(P + (size_t)(row0_ - 3 + i) * NP + PC_XR + c0_) : (half8){0, 0, 0, 0, 0, 0, 0, 0}; } \
        __builtin_amdgcn_sched_barrier(0); } while (0)
#define P3_COMP(buf, rbv, hh) do { const int c0_ = (hh) * 512 + 8 * I.lane, row0_ = (rbv) * 8; \
        _Pragma("unroll") for (int r = 0; r < 8; ++r) { f32x4 a0 = bb[hh][0], a1 = bb[hh][1]; \
            _Pragma("unroll") for (int k = 0; k < 4; ++k) { const half8 xv = buf[r + k]; \
                a0 += w[hh][k][0] * (f32x4){(float)xv[0], (float)xv[1], (float)xv[2], (float)xv[3]}; a1 += w[hh][k][1] * (f32x4){(float)xv[4], (float)xv[5], (float)xv[6], (float)xv[7]}; } \
            u32x4 o; o.x = pk2h(a0[0], a0[1]); o.y = pk2h(a0[2], a0[3]); o.z = pk2h(a1[0], a1[1]); o.w = pk2h(a1[2], a1[3]); \
            *(u32x4*)(xc + (size_t)(row0_ + r) * 1024 + c0_) = o; } \
        __builtin_amdgcn_sched_barrier(0); } while (0)
    int rb = rb_first + worker;
    if (rb < rb_last) P3_LOAD(xa, rb, 0);
    for (; rb < rb_last; rb += nworkers) {
        P3_LOAD(xb, rb, 1);
        P3_COMP(xa, rb, 0);
        if (rb + nworkers < rb_last) P3_LOAD(xa, rb + nworkers, 0);
        P3_COMP(xb, rb, 1);
    }
#undef P3_LOAD
#undef P3_COMP
}

__device__ __forceinline__ void p4_cmp2(Frame& F) {
    ArgsP ap = get_args();
    const Ids I = get_ids(F.wv);
    const float* slab = (const float*)(F.ws + WS_SLAB); const float* bias1 = (const float*)(F.ws + WS_CTL) + CW_BIAS1;
    LAS float* W2 = (LAS float*)F.lds;
    LAS float* scr = (LAS float*)(F.lds + 65536 + I.wave * 4096);
    const int NGW = F.G * NWAVES;
    int mload = -1;
    for (int g4 = F.vcu * NWAVES + I.wave; g4 < 2048; g4 += NGW) {
        const int m = g4 >> 10, r0 = (g4 & 1023) * 4;
        const int mwg = (F.vcu * NWAVES) >> 10;
        if (mload != m) {
            __syncthreads();
            const float* w2 = ap->in[m ? I_C2V : I_C2K];
            for (int i = I.tid; i < 256 * 64 / 4; i += 512) *(LAS f32x4*)(W2 + 4 * i) = *(const f32x4*)(w2 + 4 * i);
            __syncthreads(); mload = m; (void)mwg;
        }
#pragma unroll
        for (int q = 0; q < 4; ++q) { const int r = r0 + q;
            f32x4 hv = *(const f32x4*)(bias1 + m * 256 + 4 * I.lane);
#pragma unroll
            for (int s = 0; s < 2; ++s) hv += *(const f32x4*)(slab + ((size_t)s * 4096 + r) * 512 + m * 256 + 4 * I.lane);
            scr[(4 * I.lane + 0) * 4 + q] = gelu_tanh(hv.x); scr[(4 * I.lane + 1) * 4 + q] = gelu_tanh(hv.y); scr[(4 * I.lane + 2) * 4 + q] = gelu_tanh(hv.z); scr[(4 * I.lane + 3) * 4 + q] = gelu_tanh(hv.w); }
        LDS_WAIT(); asm volatile("" ::: "memory");
        f32x4 acc = {0.f, 0.f, 0.f, 0.f};
#pragma unroll 8
        for (int c = 0; c < 256; ++c) { const float w = W2[c * 64 + I.lane]; const f32x4 s4 = *(const LAS f32x4*)(scr + 4 * c); acc += s4 * w; }
        half_t* dst = (half_t*)(F.ws + (m ? WS_VCMP : WS_KCMP)) + (size_t)r0 * 64 + I.lane;
        dst[0] = (half_t)acc.x; dst[64] = (half_t)acc.y; dst[128] = (half_t)acc.z; dst[192] = (half_t)acc.w;
        LDS_WAIT(); asm volatile("" ::: "memory");
    }
}

__device__ __forceinline__ void p5_scan(Frame& F) {
    const Ids I = get_ids(F.wv);
    const unsigned* ab = (const unsigned*)(F.ws + WS_ABUF); const half_t* P = (const half_t*)(F.ws + WS_P);
    unsigned short* amix = (unsigned short*)(F.ws + WS_AMIX); float* ssr = (float*)(F.ws + WS_CTL) + CW_SSR; const float* grnn = get_args()->in[I_GRNN];
    LAS float* sA = (LAS float*)F.lds; LAS float* sB = sA + 2048; LAS float* sC = sB + 2048;
    for (int u = F.vcu; u < 256; u += F.G) {
        const int b = u >> 5, cg = u & 31, cq = I.tid & 7, seg = I.tid >> 3, c0 = cg * 32 + 4 * cq;
        const size_t row0 = (size_t)b * SEQ + seg * 32;
        float Ap[4] = {1.f, 1.f, 1.f, 1.f}, Bp[4] = {0.f, 0.f, 0.f, 0.f};
        half8 wq[32];
        { const unsigned* pw = ab + row0 * 1024 + c0;
#pragma unroll
          for (int t = 0; t < 32; ++t) { wq[t] = *(const half8*)pw; pw += 1024; asm volatile("" : "+v"(pw)); } }
        __builtin_amdgcn_sched_barrier(0);
#pragma unroll
        for (int t = 0; t < 32; ++t) { const half8 w = wq[t];
#pragma unroll
            for (int j = 0; j < 4; ++j) { const float av = 1.0f - (float)w[2 * j], bv = (float)w[2 * j + 1]; Bp[j] = av * Bp[j] + bv; Ap[j] *= av; } }
#pragma unroll
        for (int j = 0; j < 4; ++j) { sA[seg * 32 + 4 * cq + j] = Ap[j]; sB[seg * 32 + 4 * cq + j] = Bp[j]; }
        __syncthreads();
        if (I.tid < 32) { float h = 0.f;
            for (int s = 0; s < 64; ++s) { sC[s * 32 + I.tid] = h; h = sA[s * 32 + I.tid] * h + sB[s * 32 + I.tid]; } }
        __syncthreads();
        float h[4], gc[4];
#pragma unroll
        for (int j = 0; j < 4; ++j) { h[j] = sC[seg * 32 + 4 * cq + j]; gc[j] = grnn[c0 + j]; }
#pragma unroll
        for (int t = 0; t < 32; ++t) asm volatile("" : "+v"(wq[t]));
#pragma unroll
        for (int tb = 0; tb < 32; tb += 16) {
        half4 yq[16];
        { const half_t* py = P + (row0 + tb) * NP + PC_YR + c0;
#pragma unroll
          for (int t = 0; t < 16; ++t) { yq[t] = *(const half4*)py; py += NP; asm volatile("" : "+v"(py)); } }
        __builtin_amdgcn_sched_barrier(0);
#pragma unroll
        for (int tt = 0; tt < 16; ++tt) { const int t = tb + tt; const half8 w = wq[t]; const half4 yv = yq[tt];
            float o[4], q = 0.f;
#pragma unroll
            for (int j = 0; j < 4; ++j) { const float av = 1.0f - (float)w[2 * j], bv = (float)w[2 * j + 1]; h[j] = av * h[j] + bv;
                o[j] = gelu_tanh((float)yv[j]) * h[j]; q += o[j] * o[j]; }
            u32x2 ow; ow.x = pk2x<FFN_DT>(o[0] * gc[0], o[1] * gc[1]); ow.y = pk2x<FFN_DT>(o[2] * gc[2], o[3] * gc[3]);
            *(u32x2*)(amix + (row0 + t) * 2048 + 1024 + c0) = ow;
            q += __shfl_xor(q, 1); q += __shfl_xor(q, 2); q += __shfl_xor(q, 4);
            if (cq == 0) atomicAdd(ssr + row0 + t, q); }
        __builtin_amdgcn_sched_barrier(0);
        }
        __syncthreads();
    }
}

namespace att {
typedef float f32x16 __attribute__((ext_vector_type(16)));
constexpr int L_KB = 0, L_VB = 24576  , L_WSF = 49152, L_IMP = 51200, L_RES = L_IMP  , L_MASK = L_IMP + 69632, L_UM = L_MASK + 256;
constexpr int RS = 68;
constexpr float THR = 8.0f, MFLOOR = -1000.0f, NEGBIG = -1e30f;
__device__ __forceinline__ int crow(int r, int hi) { return (r & 3) + 8 * (r >> 2) + 4 * hi; }
#define ATT_SBAR() __builtin_amdgcn_sched_barrier(0)
__device__ __forceinline__ void qkt(f32x16& p0, f32x16& p1, const LAS unsigned char* Kslot, const half8 (&qr)[4], int r32, int hi) {
    const LAS unsigned char* kb = Kslot + hi * 1024 + r32 * 16;
    f32x16 a = {}, b = {};
#pragma unroll
    for (int d0 = 0; d0 < 4; ++d0) {
        const half8 b0 = *(const LAS half8*)(kb + d0 * 2048);
        const half8 b1 = *(const LAS half8*)(kb + d0 * 2048 + 512);
        a = __builtin_amdgcn_mfma_f32_32x32x16_f16(b0, qr[d0], a, 0, 0, 0);
        b = __builtin_amdgcn_mfma_f32_32x32x16_f16(b1, qr[d0], b, 0, 0, 0);
    }
    p0 = a; p1 = b;
}
__device__ __forceinline__ float rowmax(const f32x16& p0, const f32x16& p1) {
    float a = fmaxf(p0[0], p1[0]);
#pragma unroll
    for (int r = 1; r < 16; ++r) a = fmaxf(a, fmaxf(p0[r], p1[r]));
    auto rr = __builtin_amdgcn_permlane32_swap(__float_as_uint(a), __float_as_uint(a), false, false);
    return fmaxf(__uint_as_float(rr[0]), __uint_as_float(rr[1]));
}
__device__ __forceinline__ void pv(f32x16 (&o)[2], int vb, half8 pa0, half8 pa1, half8 pa2, half8 pa3) {
    half4 lo[2][4], hi[2][4];
#pragma unroll
    for (int d0 = 0; d0 < 2; ++d0)
#pragma unroll
        for (int ks = 0; ks < 4; ++ks) {
            asm volatile("ds_read_b64_tr_b16 %0,%1 offset:%c2" : "=&v"(lo[d0][ks]) : "v"(vb), "i"(d0 * 4096 + ks * 1024) : "memory");
            asm volatile("ds_read_b64_tr_b16 %0,%1 offset:%c2" : "=&v"(hi[d0][ks]) : "v"(vb), "i"(d0 * 4096 + ks * 1024 + 512) : "memory"); }
    asm volatile("s_waitcnt lgkmcnt(0)" ::: "memory"); ATT_SBAR();
#define ATT_PK(d, k) (half8){lo[d][k][0], lo[d][k][1], lo[d][k][2], lo[d][k][3], hi[d][k][0], hi[d][k][1], hi[d][k][2], hi[d][k][3]}
#pragma unroll
    for (int d0 = 0; d0 < 2; ++d0) {
        o[d0] = __builtin_amdgcn_mfma_f32_32x32x16_f16(pa0, ATT_PK(d0, 0), o[d0], 0, 0, 0);
        o[d0] = __builtin_amdgcn_mfma_f32_32x32x16_f16(pa1, ATT_PK(d0, 1), o[d0], 0, 0, 0);
        o[d0] = __builtin_amdgcn_mfma_f32_32x32x16_f16(pa2, ATT_PK(d0, 2), o[d0], 0, 0, 0);
        o[d0] = __builtin_amdgcn_mfma_f32_32x32x16_f16(pa3, ATT_PK(d0, 3), o[d0], 0, 0, 0);
    }
#undef ATT_PK
}
__device__ __forceinline__ half8 pack8(const f32x16& p, int b) {
    u32x4 w; w.x = pk2h(p[b + 0], p[b + 1]); w.y = pk2h(p[b + 2], p[b + 3]); w.z = pk2h(p[b + 4], p[b + 5]); w.w = pk2h(p[b + 6], p[b + 7]);
    return __builtin_bit_cast(half8, w);
}
__device__ __forceinline__ void load_kv(LAS unsigned char* lds, int kslot, int vslot, const unsigned char* kbase, const unsigned char* vbase, size_t pitch, int wid, int lane) {
    const unsigned char* ks = kbase + (size_t)lane * pitch + wid * 16;
    const unsigned char* vs = vbase + (size_t)(16 * (wid & 3) + (lane >> 2)) * pitch + (wid >> 2) * 64 + (lane & 3) * 16;
    __builtin_amdgcn_global_load_lds((const unsigned*)ks, (LAS unsigned*)(lds + kslot + wid * 1024), 16, 0, 0);
    __builtin_amdgcn_global_load_lds((const unsigned*)vs, (LAS unsigned*)(lds + vslot + wid * 1024), 16, 0, 0);
}
#define ATT_RING_SYNC(ahead) do { if ((ahead) >= 1) asm volatile("s_waitcnt vmcnt(2) lgkmcnt(0)" ::: "memory"); else asm volatile("s_waitcnt vmcnt(0) lgkmcnt(0)" ::: "memory"); \
    __builtin_amdgcn_s_barrier(); asm volatile("" ::: "memory"); } while (0)
#define ATT_SYNC() do { asm volatile("s_waitcnt vmcnt(0) lgkmcnt(0)" ::: "memory"); __syncthreads(); } while (0)

__device__ __forceinline__ float max3f(float a, float b, float c) { float r; asm("v_max3_f32 %0, %1, %2, %3" : "=v"(r) : "v"(a), "v"(b), "v"(c)); return r; }
__device__ __forceinline__ float max2f(float a, float b) { float r; asm("v_max_f32_e32 %0, %1, %2" : "=v"(r) : "v"(a), "v"(b)); return r; }
__device__ __forceinline__ float rowmax3(const f32x16& p0, const f32x16& p1) {
    float a = max3f(p0[0], p0[1], p1[0]), b = max3f(p0[2], p0[3], p1[1]); a = max3f(a, p1[2], p1[3]);
#pragma unroll
    for (int r = 4; r < 16; r += 4) { a = max3f(a, p0[r], p0[r + 1]); b = max3f(b, p0[r + 2], p0[r + 3]); a = max3f(a, p1[r], p1[r + 1]); b = max3f(b, p1[r + 2], p1[r + 3]); }
    const float m = max2f(a, b);
    auto rr = __builtin_amdgcn_permlane32_swap(__float_as_uint(m), __float_as_uint(m), false, false);
    return max2f(__uint_as_float(rr[0]), __uint_as_float(rr[1]));
}
template <int AV = 0>
__device__ __forceinline__ void qkt_c(f32x16& p0, f32x16& p1, const LAS unsigned char* Kslot, const half8 (&qr)[4], const f32x16& cin, int r32, int hi) {
    if (AV == 3) { p0 = cin; p1 = cin; return; }
    const LAS unsigned char* kb = Kslot + hi * 1024 + r32 * 16;
    half8 kf[8];
#pragma unroll
    for (int d0 = 0; d0 < 4; ++d0) { kf[2 * d0] = *(const LAS half8*)(kb + d0 * 2048); kf[2 * d0 + 1] = *(const LAS half8*)(kb + d0 * 2048 + 512); }
    __builtin_amdgcn_sched_barrier(0);
    f32x16 a = cin, b = cin;
#pragma unroll
    for (int d0 = 0; d0 < 4; ++d0) {
        a = __builtin_amdgcn_mfma_f32_32x32x16_f16(kf[2 * d0], qr[d0], a, 0, 0, 0);
        b = __builtin_amdgcn_mfma_f32_32x32x16_f16(kf[2 * d0 + 1], qr[d0], b, 0, 0, 0);
    }
    p0 = a; p1 = b;
}
struct SmState { f32x16 o[2]; float lsum; float mhat; };
__device__ __forceinline__ void sm_init(SmState& S) { S.o[0] = f32x16{}; S.o[1] = f32x16{}; S.lsum = 0.f; S.mhat = MFLOOR; }
__device__ __forceinline__ f32x16 splat16(float v) { f32x16 c;
#pragma unroll
    for (int r = 0; r < 16; ++r) c[r] = v;
    return c; }
#define MUL_IP(x, f) do { float t_ = (x); asm volatile("v_mul_f32_e32 %0, %1, %0" : "+v"(t_) : "v"(f)); (x) = t_; } while (0)
#define SUB_IP(x, d) do { float t_ = (x); asm volatile("v_sub_f32_e32 %0, %0, %1" : "+v"(t_) : "v"(d)); (x) = t_; } while (0)
#define MIN_IP(x, b) do { float t_ = (x); asm volatile("v_min_f32_e32 %0, %1, %0" : "+v"(t_) : "v"(b)); (x) = t_; } while (0)
template <int MASK>
__device__ __forceinline__ void mask_tile(f32x16& p0, f32x16& p1, int hi, int tl) {
    asm volatile("s_nop 15\n\ts_nop 7" : "+v"(p0), "+v"(p1));
    const float INF = __builtin_inff();
#pragma unroll
    for (int r = 0; r < 16; ++r) { const int kl = crow(r, hi);
        const bool k0 = (MASK == 1) ? (kl <= tl) : (kl > tl), k1 = (MASK == 1) ? (kl + 32 <= tl) : (kl + 32 > tl);
        const float b0 = k0 ? INF : NEGBIG, b1 = k1 ? INF : NEGBIG; MIN_IP(p0[r], b0); MIN_IP(p1[r], b1); }
}
template <int AV = 0>
__device__ __forceinline__ void sm_tile(f32x16& p0, f32x16& p1, SmState& S, LAS float* wsf, int r32, int hi, int vb, half8 ones) {
    asm volatile("s_nop 15\n\ts_nop 7" : "+v"(p0), "+v"(p1));
    const float rm = rowmax3(p0, p1);
    if (__any(rm > THR)) {
        const float dl = fmaxf(rm, 0.f), f = __builtin_amdgcn_exp2f(-dl); S.mhat += dl;
#pragma unroll
        for (int r = 0; r < 16; ++r) { SUB_IP(p0[r], dl); SUB_IP(p1[r], dl); }
        if (hi == 0) wsf[r32] = f;
        asm volatile("s_waitcnt lgkmcnt(0)" ::: "memory");
#pragma unroll
        for (int r = 0; r < 16; ++r) { const float fr = wsf[crow(r, hi)]; MUL_IP(S.o[0][r], fr); MUL_IP(S.o[1][r], fr); }
        S.lsum *= f;
        asm volatile("s_waitcnt lgkmcnt(0)" ::: "memory");
    }
#pragma unroll
    for (int r = 0; r < 16; ++r) { if (AV != 1) { p0[r] = __builtin_amdgcn_exp2f(p0[r]); p1[r] = __builtin_amdgcn_exp2f(p1[r]); } }
    const half8 pa0 = pack8(p0, 0), pa1 = pack8(p0, 8), pa2 = pack8(p1, 0), pa3 = pack8(p1, 8);
    if (AV != 5) { const f32x16 ps = p0 + p1;
        S.lsum += (((ps[0] + ps[1]) + (ps[2] + ps[3])) + ((ps[4] + ps[5]) + (ps[6] + ps[7]))) + (((ps[8] + ps[9]) + (ps[10] + ps[11])) + ((ps[12] + ps[13]) + (ps[14] + ps[15]))); }
    if (AV != 2) pv(S.o, vb, pa0, pa1, pa2, pa3);
    else { asm volatile("" :: "v"(pa0), "v"(pa1), "v"(pa2), "v"(pa3)); }
}
__device__ __forceinline__ void sm_scale(SmState& S, float gate, LAS float* wsf, int r32, int hi) {
    float lt = S.lsum;
    { auto rr = __builtin_amdgcn_permlane32_swap(__float_as_uint(lt), __float_as_uint(lt), false, false); lt = __uint_as_float(rr[0]) + __uint_as_float(rr[1]); }
    const float val = (lt > 0.f) ? gate * __builtin_amdgcn_rcpf(lt) : 0.f;
    if (hi == 0) wsf[r32] = val;
    asm volatile("s_waitcnt lgkmcnt(0)" ::: "memory");
#pragma unroll
    for (int r = 0; r < 16; ++r) { const float fr = wsf[crow(r, hi)]; S.o[0][r] *= fr; S.o[1][r] *= fr; }
    asm volatile("s_waitcnt lgkmcnt(0)" ::: "memory");
}
__device__ __forceinline__ void add_scaled(f32x16 (&res)[2], const f32x16 (&o)[2], float sc, LAS float* wsf, int r32, int hi) {
    if (hi == 0) wsf[r32] = sc;
    asm volatile("s_waitcnt lgkmcnt(0)" ::: "memory");
#pragma unroll
    for (int r = 0; r < 16; ++r) { const float fr = wsf[crow(r, hi)]; res[0][r] += o[0][r] * fr; res[1][r] += o[1][r] * fr; }
    asm volatile("s_waitcnt lgkmcnt(0)" ::: "memory");
}

template <int PARTS, int AV = 0>
__device__ __forceinline__ void unit(LAS unsigned char* lds, unsigned char* ws, const float* gatt, int b, int g, int qt, int tid) {
    asm volatile("" : "+v"(tid));
    asm volatile("" : "+s"(ws));
    const int lane = tid & 63, wid = __builtin_amdgcn_readfirstlane(tid >> 6), r32 = lane & 31, hi = lane >> 5, hg = wid & 3, qs = wid >> 2, h = g * 4 + hg;
    const half_t* P = (const half_t*)(ws + WS_P);
    const int tl = 32 * qs + r32;
    const int t = 64 * qt + tl; const size_t row = (size_t)b * SEQ + t;
    LAS float* wsf = (LAS float*)(lds + L_WSF) + wid * 64;
    const int vb0 = (int)(unsigned)(uintptr_t)(lds + L_VB) + ((lane >> 4) & 1) * 32 + (lane & 3) * 8 + (4 * hi + ((lane & 15) >> 2)) * 64;
    const size_t pitch = (size_t)NP * 2;
    {
        const unsigned char* kc = (const unsigned char*)(ws + WS_KCMP) + ((size_t)(b * 128) * 4 + g) * 128;
        const unsigned char* vc = (const unsigned char*)(ws + WS_VCMP) + ((size_t)(b * 128) * 4 + g) * 128;
        load_kv(lds, L_KB, L_VB, kc, vc, 512, wid, lane);
        if (qt >= 16) load_kv(lds, L_KB + 8192, L_VB + 8192, kc + 64 * 512, vc + 64 * 512, 512, wid, lane);
    }
    half8 qr[4];
    { const half_t* qp = P + row * NP + PC_Q + h * 64 + hi * 8;
#pragma unroll
      for (int d0 = 0; d0 < 4; ++d0) qr[d0] = *(const half8*)(qp + 16 * d0); }
    const half_t* glp = P + row * NP + PC_GL + h * 3;
    const float g0 = sigmoidf_((float)glp[0]), g1 = sigmoidf_((float)glp[1]), g2 = sigmoidf_((float)glp[2]);
    if (tid == 0) *(LAS unsigned*)(lds + L_UM) = 0u;
    f32x16 oc[2];
    ATT_SYNC();
    {
        const bool two = (qt >= 16);
        f32x16 s0, s1, s2, s3;
        qkt(s0, s1, lds + L_KB, qr, r32, hi);
        if (two) qkt(s2, s3, lds + L_KB + 8192, qr, r32, hi); else { s2 = splat16(NEGBIG); s3 = s2; }
        const int nvalid = (t >= 31) ? ((t - 31) / 16 + 1) : 0;
#pragma unroll
        for (int r = 0; r < 16; ++r) { const int n = crow(r, hi);
            if (n >= nvalid) s0[r] = NEGBIG; if (n + 32 >= nvalid) s1[r] = NEGBIG; if (n + 64 >= nvalid) s2[r] = NEGBIG; if (n + 96 >= nvalid) s3[r] = NEGBIG; }
        const float mc = fmaxf(fmaxf(rowmax(s0, s1), two ? rowmax(s2, s3) : NEGBIG), MFLOOR);
        float ls = 0.f;
#pragma unroll
        for (int r = 0; r < 16; ++r) { s0[r] = __builtin_amdgcn_exp2f(s0[r] - mc); s1[r] = __builtin_amdgcn_exp2f(s1[r] - mc); ls += s0[r] + s1[r]; }
        if (two) {
#pragma unroll
            for (int r = 0; r < 16; ++r) { s2[r] = __builtin_amdgcn_exp2f(s2[r] - mc); s3[r] = __builtin_amdgcn_exp2f(s3[r] - mc); ls += s2[r] + s3[r]; }
        }
        { auto rr = __builtin_amdgcn_permlane32_swap(__float_as_uint(ls), __float_as_uint(ls), false, false); ls = __uint_as_float(rr[0]) + __uint_as_float(rr[1]); }
        const float rl = (ls > 0.f) ? 1.0f / ls : 0.f;
#pragma unroll
        for (int r = 0; r < 16; ++r) { s0[r] *= rl; s1[r] *= rl; }
        if (two) {
#pragma unroll
            for (int r = 0; r < 16; ++r) { s2[r] *= rl; s3[r] *= rl; }
        }
        LAS float* imp = (LAS float*)(lds + L_IMP) + hg * 2048 + tl;
#define ATT_IMPA(S, TI, HF) _Pragma("unroll") for (int gq = 0; gq < 4; ++gq) { const int J = 16 * (TI) + 8 * (HF) + 2 * gq + hi; imp[J * 64] = (S[4 * gq] + S[4 * gq + 1]) + (S[4 * gq + 2] + 0.5f * S[4 * gq + 3]); }
        ATT_IMPA(s0, 0, 0) ATT_IMPA(s1, 0, 1)
        if (two) { ATT_IMPA(s2, 1, 0) ATT_IMPA(s3, 1, 1) }
#undef ATT_IMPA
        asm volatile("s_waitcnt lgkmcnt(0)" ::: "memory");
#define ATT_IMPB(S, TI, HF) _Pragma("unroll") for (int gq = 0; gq < 4; ++gq) { const int J = 16 * (TI) + 8 * (HF) + 2 * gq + hi + 1; if (J < 32) imp[J * 64] += 0.5f * S[4 * gq + 3]; }
        ATT_IMPB(s0, 0, 0) ATT_IMPB(s1, 0, 1)
        if (two) { ATT_IMPB(s2, 1, 0) ATT_IMPB(s3, 1, 1) }
#undef ATT_IMPB
        f32x16 o[2]; o[0] = f32x16{}; o[1] = f32x16{};
        pv(o, vb0, pack8(s0, 0), pack8(s0, 8), pack8(s1, 0), pack8(s1, 8));
        if (two) pv(o, vb0 + 8192, pack8(s2, 0), pack8(s2, 8), pack8(s3, 0), pack8(s3, 8));
        oc[0] = f32x16{}; oc[1] = f32x16{};
        add_scaled(oc, o, g0, wsf, r32, hi);
    }
    ATT_SYNC();
    if (PARTS & 1) load_kv(lds, L_KB, L_VB, (const unsigned char*)(P + (size_t)b * SEQ * NP + PC_KS + g * 64), (const unsigned char*)(P + (size_t)b * SEQ * NP + PC_VS + g * 64), pitch, wid, lane);
    {
        const int q = tid >> 3, sub = tid & 7, cur = qt; unsigned mask;
        if (cur <= 7) mask = (2u << cur) - 1u;
        else {
            const LAS float* ip = (const LAS float*)(lds + L_IMP) + q;
            float iv[4];
#pragma unroll
            for (int j = 0; j < 4; ++j) { const int J = sub * 4 + j; iv[j] = (ip[J * 64] + ip[2048 + J * 64]) + (ip[4096 + J * 64] + ip[6144 + J * 64]);
                if (J < 1 || J > cur - 2) iv[j] = -1.0f; }
            mask = 1u | (1u << cur) | (1u << (cur - 1));
            for (int rnd = 0; rnd < 5; ++rnd) {
                float bv = iv[0]; int bi = sub * 4;
#pragma unroll
                for (int j = 1; j < 4; ++j) if (iv[j] > bv) { bv = iv[j]; bi = sub * 4 + j; }
#pragma unroll
                for (int x = 1; x < 8; x <<= 1) { const float ov = __shfl_xor(bv, x); const int oi = __shfl_xor(bi, x); if (ov > bv || (ov == bv && oi < bi)) { bv = ov; bi = oi; } }
                mask |= 1u << bi;
#pragma unroll
                for (int j = 0; j < 4; ++j) if (bi == sub * 4 + j) iv[j] = -2.0f;
            }
        }
        if (sub == 0) { ((LAS unsigned*)(lds + L_MASK))[q] = mask; if ((tid & 63) == 0) {} }
        if (sub == 0) __hip_atomic_fetch_or((LAS unsigned*)(lds + L_UM), mask, __ATOMIC_RELAXED, __HIP_MEMORY_SCOPE_WORKGROUP);
    }
    ATT_SYNC();
    const unsigned msk = ((const LAS unsigned*)(lds + L_MASK))[tl];
    const unsigned um = (unsigned)__builtin_amdgcn_readfirstlane(*(const LAS unsigned*)(lds + L_UM));
    LAS float* resl = (LAS float*)(lds + L_RES) + wid * (32 * RS) + r32;
#pragma unroll
    for (int r = 0; r < 16; ++r) { resl[crow(r, hi) * RS] = oc[0][r]; resl[crow(r, hi) * RS + 32] = oc[1][r]; }
    const half8 ones = {(half_t)1.0f, (half_t)1.0f, (half_t)1.0f, (half_t)1.0f, (half_t)1.0f, (half_t)1.0f, (half_t)1.0f, (half_t)1.0f};
    if (PARTS & 1) {
        const unsigned char* kbase = (const unsigned char*)(P + (size_t)b * SEQ * NP + PC_KS + g * 64);
        const unsigned char* vbase = (const unsigned char*)(P + (size_t)b * SEQ * NP + PC_VS + g * 64);
        SmState S; sm_init(S);
        const int NT = __builtin_popcount(um);
        unsigned rem = um; int kt = __builtin_ctz(rem); rem &= rem - 1u;
        int n1 = rem ? __builtin_ctz(rem) : 0; rem &= rem - 1u;
        int n2 = rem ? __builtin_ctz(rem) : 0; rem &= rem - 1u;
        if (NT > 1) load_kv(lds, L_KB + 8192, L_VB + 8192, kbase + (size_t)n1 * 64 * pitch, vbase + (size_t)n1 * 64 * pitch, pitch, wid, lane);
        int sc = 0, sn = 16384;
        for (int i = 0; i < NT; ++i) {
            ATT_RING_SYNC(NT - 1 - i);
            if (i + 2 < NT && AV != 4) load_kv(lds, L_KB + sn, L_VB + sn, kbase + (size_t)n2 * 64 * pitch, vbase + (size_t)n2 * 64 * pitch, pitch, wid, lane);
            const bool bit = (msk >> kt) & 1u;
            if (__any(bit)) {
                f32x16 p0, p1; qkt_c<AV>(p0, p1, lds + L_KB + sc, qr, splat16(bit ? -S.mhat : NEGBIG), r32, hi);
                if (kt == qt) mask_tile<1>(p0, p1, hi, tl);
                sm_tile<AV>(p0, p1, S, wsf, r32, hi, vb0 + sc, ones);
            }
            kt = n1; n1 = n2; n2 = rem ? __builtin_ctz(rem) : 0; rem &= rem - 1u;
            sc = (sc == 16384) ? 0 : sc + 8192; sn = (sn == 16384) ? 0 : sn + 8192;
        }
        sm_scale(S, g1, wsf, r32, hi);
#pragma unroll
        for (int r = 0; r < 16; ++r) { resl[crow(r, hi) * RS] += S.o[0][r]; resl[crow(r, hi) * RS + 32] += S.o[1][r]; }
    }
    ATT_SYNC();
    if (PARTS & 2) {
        const unsigned char* kbase = (const unsigned char*)(P + (size_t)b * SEQ * NP + PC_KW + g * 64);
        const unsigned char* vbase = (const unsigned char*)(P + (size_t)b * SEQ * NP + PC_VW + g * 64);
        SmState S; sm_init(S);
        const int kt0 = qt >= 8 ? qt - 8 : 0, NT = qt - kt0 + 1;
        kbase += (size_t)kt0 * 64 * pitch; vbase += (size_t)kt0 * 64 * pitch;
        load_kv(lds, L_KB, L_VB, kbase, vbase, pitch, wid, lane);
        if (NT > 1) load_kv(lds, L_KB + 8192, L_VB + 8192, kbase + (size_t)64 * pitch, vbase + (size_t)64 * pitch, pitch, wid, lane);
        int sc = 0, sn = 16384;
        for (int i = 0; i < NT; ++i) {
            ATT_RING_SYNC(NT - 1 - i);
            if (i + 2 < NT && AV != 4) load_kv(lds, L_KB + sn, L_VB + sn, kbase + (size_t)(i + 2) * 64 * pitch, vbase + (size_t)(i + 2) * 64 * pitch, pitch, wid, lane);
            const int kt = kt0 + i;
            f32x16 p0, p1; qkt_c<AV>(p0, p1, lds + L_KB + sc, qr, splat16(-S.mhat), r32, hi);
            if (kt == qt) mask_tile<1>(p0, p1, hi, tl);
            else if (kt == qt - 8) mask_tile<2>(p0, p1, hi, tl);
            sm_tile<AV>(p0, p1, S, wsf, r32, hi, vb0 + sc, ones);
            sc = (sc == 16384) ? 0 : sc + 8192; sn = (sn == 16384) ? 0 : sn + 8192;
        }
        sm_scale(S, g2, wsf, r32, hi);
#pragma unroll
        for (int r = 0; r < 16; ++r) { resl[crow(r, hi) * RS] += S.o[0][r]; resl[crow(r, hi) * RS + 32] += S.o[1][r]; }
        asm volatile("s_waitcnt lgkmcnt(0)" ::: "memory");
        {
            const int kc = lane & 7;
            const float* gp = gatt + h * 64 + 8 * kc;
            const f32x4 g0 = *(const f32x4*)(gp), g1 = *(const f32x4*)(gp + 4);
#pragma unroll
            for (int jj = 0; jj < 4; ++jj) {
                const int orow = 8 * jj + (lane >> 3);
                const LAS float* rp = (const LAS float*)(lds + L_RES) + wid * (32 * RS) + orow * RS + 8 * kc;
                const size_t rowg = (size_t)b * SEQ + 64 * qt + 32 * qs + orow;
                const f32x4 v0 = *(const LAS f32x4*)(rp), v1 = *(const LAS f32x4*)(rp + 4);
                float ss = (v0[0] * v0[0] + v0[1] * v0[1]) + (v0[2] * v0[2] + v0[3] * v0[3]) + (v1[0] * v1[0] + v1[1] * v1[1]) + (v1[2] * v1[2] + v1[3] * v1[3]);
                u32x4 w; w.x = pk2x<FFN_DT>(v0[0] * g0[0], v0[1] * g0[1]); w.y = pk2x<FFN_DT>(v0[2] * g0[2], v0[3] * g0[3]); w.z = pk2x<FFN_DT>(v1[0] * g1[0], v1[1] * g1[1]); w.w = pk2x<FFN_DT>(v1[2] * g1[2], v1[3] * g1[3]);
                if (AV == 0) *(u32x4*)((half_t*)(ws + WS_AMIX) + rowg * 2048 + h * 64 + 8 * kc) = w; else asm volatile("" :: "v"(w));
                ss += __shfl_xor(ss, 1); ss += __shfl_xor(ss, 2); ss += __shfl_xor(ss, 4);
                if (kc == 0 && AV == 0) atomicAdd((float*)(ws + WS_CTL) + CW_SSA + rowg, ss); else asm volatile("" :: "v"(ss));
            }
        }
    }
    ATT_SYNC();
}
#undef ATT_SBAR
#undef ATT_SYNC
}

template <int AV = 0>
__device__ __forceinline__ void p5_attn(Frame& F) {
    if (F.G == 256 && AV == 0) {
        const int xq = F.vcu >> 5;
        unsigned* qc = (unsigned*)(F.ws + WS_CTL) + CW_ATTQ + 64 * xq;
        volatile LAS unsigned* slot = (volatile LAS unsigned*)(F.lds + MISC_OFF + 64);
        const bool lead = (F.wv == 0) && (lane_id() == 0);
        unsigned nxt = 0u;
        if (lead) { nxt = __hip_atomic_fetch_add(qc, 1u, __ATOMIC_RELAXED, __HIP_MEMORY_SCOPE_AGENT); *slot = nxt; }
        __syncthreads();
        unsigned cur = (unsigned)__builtin_amdgcn_readfirstlane(*slot);
        while (cur < 128u) {
            if (lead) nxt = __hip_atomic_fetch_add(qc, 1u, __ATOMIC_RELAXED, __HIP_MEMORY_SCOPE_AGENT);
            const int qt = 31 - (int)(cur >> 2), bg = 4 * xq + (int)(cur & 3u);
            att::unit<3, 0>(F.lds, F.ws, get_args()->in[I_GATT], bg >> 2, bg & 3, qt, make_tid(F.wv));
            if (lead) *slot = nxt;
            __syncthreads();
            cur = (unsigned)__builtin_amdgcn_readfirstlane(*slot);
        }
        return;
    }
    for (int v = F.vcu; v < 256; v += F.G) {
        const int bg = v >> 3, s = v & 7;
        const unsigned qpack = (s == 0) ? 0x0110111fu : (s == 1) ? 0x000e161du : (s == 2) ? 0x020d121eu : (s == 3) ? 0x030c171au : (s == 4) ? 0x0409141cu : (s == 5) ? 0x050a131bu : (s == 6) ? 0x06071519u : 0x080b0f18u;
        for (int i = 0; i < 4; ++i) { const int qt = (int)((qpack >> (8 * i)) & 0xffu);
            att::unit<(AV == 7) ? 0 : (AV == 8) ? 1 : 3, AV>(F.lds, F.ws, get_args()->in[I_GATT], bg >> 2, bg & 3, qt, make_tid(F.wv)); }
    }
}

constexpr int NPHASES = 13;
__global__ void __launch_bounds__(NWAVES * 64, 2) mega_fwd(Args args_unused) {
    extern __shared__ __attribute__((aligned(16))) unsigned char lds_raw[];
    Frame F;
    ArgsP args = get_args();
    F.lds = (LAS unsigned char*)lds_raw; F.ws = args->ws;
    F.wv = __builtin_amdgcn_readfirstlane((int)threadIdx.x >> 6);
    F.G = gridDim.x; { const int bx = blockIdx.x; F.vcu = (F.G % 8 == 0) ? (bx % 8) * (F.G / 8) + bx / 8 : bx; }
    volatile LAS unsigned* MISC = (volatile LAS unsigned*)(F.lds + MISC_OFF);
    for (int u = make_tid(F.wv); u < (LDS_BYTES - LDSCTL_OFF) / 4; u += NWAVES * 64) ((LAS unsigned*)(F.lds + LDSCTL_OFF))[u] = 0u;
    __syncthreads();
    gu32* ctl = (gu32*)(F.ws + WS_CTL);
    XcdBarrier bar; bar.bar = (unsigned*)(ctl + CW_BAR); bar.x = 0; bar.st = nullptr; bar.wv = F.wv;
    const int lo = args->ph_lo, hi = args->ph_hi;
    const bool multi = (hi - lo) > 1;
    if (multi) bar = xcd_barrier_post((unsigned*)(ctl + CW_BAR), MISC + 8, F.wv);
#define IN(k) (lo <= (k) && (k) < hi)
#define REP(k) for (int rep_ = 0; rep_ < ((((PROBE_REP) >> (k)) & 1) ? 2 : 1); ++rep_)
#define SEAM(k) do { if (IN(k) && IN((k) + 1)) xcd_barrier(bar); } while (0)
    unsigned char* ws = F.ws;

    if (IN(0)) REP(0) { p0_prologue(F, rep_); } SEAM(0);
    if (IN(1)) REP(1) { p1_norm(F); } SEAM(1);
    const bool p3_in_p2 = (F.G == 256);
    if (IN(2)) REP(2) {
        pg8::GeoPlain g{(const half_t*)(ws + WS_HBUF), (const half_t*)(ws + WS_WIN), DM, DM};
        if (p3_in_p2) {
            pg8::ProjOrder S; S.init(NTOK / 256, NP / 256, F.G, (int)blockIdx.x); S.cnt = (unsigned*)(ws + WS_CTL) + CW_P2CNT; S.wv = F.wv;
            pg8::EpiF16<3> E{(half_t*)(ws + WS_P), NP, nullptr};
            pg8::gemm_phase<pg8::GeoPlain, pg8::EpiF16<3>, pg8::ProjOrder, true, true, PROJ_DT>(F.lds, g, S, E, F.wv);
            const int c = (int)blockIdx.x, busy = ((NTOK / 256) * (NP / 256)) % 256;
            if (c >= busy) {
                const int gid = c & 7, j = (c - busy) >> 3;
                if (F.wv == 0) { unsigned* cn = (unsigned*)(ws + WS_CTL) + CW_P2CNT + 64 * gid; unsigned sp = 0;
                    while ((unsigned)__builtin_amdgcn_readfirstlane(__hip_atomic_load(cn, __ATOMIC_RELAXED, __HIP_MEMORY_SCOPE_AGENT)) < 32u) { __builtin_amdgcn_s_sleep(4); if (++sp > (1u << 22)) break; }
                    __builtin_amdgcn_fence(__ATOMIC_ACQUIRE, "agent"); asm volatile("s_waitcnt vmcnt(0)" ::: "memory"); }
                __syncthreads();
                p3_conv(F, gid * 256 + j * 32, gid * 256 + j * 32 + 32, F.wv, NWAVES);
                __syncthreads();
                pg8::GeoCmp gc{(const half_t*)(ws + WS_P), (const half_t*)(ws + WS_WC1)};
                pg8::ListOrder L{j, 1, 2 * gid, 4};
                pg8::EpiSlab Es{(float*)(ws + WS_SLAB)};
                pg8::gemm_phase<pg8::GeoCmp, pg8::EpiSlab, pg8::ListOrder, true, true>(F.lds, gc, L, Es, F.wv);
            }
        } else {
            pg8::StaticOrder S; S.init(NTOK / 256, NP / 256, F.G, (int)blockIdx.x);
            pg8::EpiF16<3> E{(half_t*)(ws + WS_P), NP, nullptr};
            pg8::gemm_phase<pg8::GeoPlain, pg8::EpiF16<3>, pg8::StaticOrder, true, true, PROJ_DT>(F.lds, g, S, E, F.wv);
        }
    } SEAM(2);
    if (IN(3) && !p3_in_p2) REP(3) {
        p3_conv(F, 0, NTOK / 8, F.vcu * NWAVES + F.wv, F.G * NWAVES);
        __syncthreads();
        pg8::GeoCmp g{(const half_t*)(ws + WS_P), (const half_t*)(ws + WS_WC1)};
        pg8::StaticOrder S; S.init(16, 4, F.G, (int)blockIdx.x);
        pg8::EpiSlab E{(float*)(ws + WS_SLAB)};
        pg8::gemm_phase<pg8::GeoCmp, pg8::EpiSlab, pg8::StaticOrder, true, true>(F.lds, g, S, E, F.wv);
    }
    if (!p3_in_p2) SEAM(3);
    if (IN(4)) REP(4) {
        pg8::GeoGates g{(const half_t*)(ws + WS_XC), (const half_t*)(ws + WS_WRG)};
        pg8::StaticOrder S; S.init(NTOK / 256, 8, F.G, (int)blockIdx.x);
        ArgsP ap = get_args();
        { LAS float* tab = (LAS float*)(F.lds + pg8::XTAB_OFF); const float* sp8 = (const float*)(ws + WS_SP8);
          for (int i = make_tid(F.wv); i < 3072; i += NWAVES * 64) tab[i] = (i < 1024) ? ap->in[I_BRGA][i] : (i < 2048) ? ap->in[I_BRGX][i - 1024] : sp8[i - 2048];
          __syncthreads(); }
        pg8::EpiGates E{(const half_t*)(ws + WS_XC), (const LAS float*)(F.lds + pg8::XTAB_OFF), (unsigned*)(ws + WS_ABUF)};
        pg8::gemm_phase<pg8::GeoGates, pg8::EpiGates, pg8::StaticOrder, true, true, 0, 1>(F.lds, g, S, E, F.wv);
        __syncthreads();
        p4_cmp2(F);
    } SEAM(4);
    if (IN(5)) { for (int r_ = 0; r_ <= PROBE_SCAN; ++r_) { p5_scan(F); __syncthreads(); } p5_attn<0>(F);
#if PROBE_ATT
        p5_attn<PROBE_AV>(F);
#endif
    } SEAM(5);
    if (IN(8)) REP(8) {
        pg8::GeoPlain g{(const half_t*)(ws + WS_AMIX), (const half_t*)(ws + WS_WOUT), DM, DM};
        pg8::PanelOrder S{F.vcu};
        pg8::PanelXchg x1{(float*)(ws + WS_XSLOT), (unsigned*)(ws + WS_CTL) + CW_PANEL}, x2{(float*)(ws + WS_XSLOT) + (size_t)NTOK * 8, (unsigned*)(ws + WS_CTL) + CW_PANEL + 4096};
        pg8::EpiX1H2 E{(const float*)(ws + WS_PAR), (half_t*)(ws + WS_X1H), (half_t*)(ws + WS_H2), x1, x2, (const float*)(ws + WS_CTL) + CW_SSA, (const float*)(ws + WS_CTL) + CW_SSR};
        pg8::gemm_phase<pg8::GeoPlain, pg8::EpiX1H2, pg8::PanelOrder, true, true, FFN_DT>(F.lds, g, S, E, F.wv);
    } SEAM(8);
    if (IN(10)) REP(10) {
        pg8::GeoPlain g{(const half_t*)(ws + WS_H2), (const half_t*)(ws + WS_WFF1), DM, DM};
        pg8::StaticOrder S; S.init(NTOK / 256, DFF / 256, F.G, (int)blockIdx.x);
        pg8::EpiF16<1, FFN_DT> E{(half_t*)(ws + WS_U), DFF, nullptr};
        pg8::gemm_phase<pg8::GeoPlain, pg8::EpiF16<1, FFN_DT>, pg8::StaticOrder, true, true, FFN_DT>(F.lds, g, S, E, F.wv);
    } SEAM(10);
    if (IN(11)) REP(11) {
        ArgsP ap = get_args();
        pg8::GeoPlain g{(const half_t*)(ws + WS_U), (const half_t*)(ws + WS_WFF2), DFF, DFF};
        pg8::PanelOrder S{F.vcu};
        pg8::PanelXchg xs{(float*)(ws + WS_XSLOT) + (size_t)NTOK * 16, (unsigned*)(ws + WS_CTL) + CW_PANEL + 8192};
        pg8::EpiFinal E{(const half_t*)(ws + WS_X1H), (const float*)(ws + WS_PAR), ap->out, xs};
        pg8::gemm_phase<pg8::GeoPlain, pg8::EpiFinal, pg8::PanelOrder, true, true, FFN_DT>(F.lds, g, S, E, F.wv);
    }
#undef IN
#undef SEAM
}

extern "C" void kernel_launch(void* const* d_in, const int* in_sizes, int n_in, void* d_out, int out_size, void* d_ws, size_t ws_size, hipStream_t stream) {
    static int grid = 0;
    if (grid == 0) {
        if (n_in != 27 || in_sizes[0] != NTOK * DM || out_size != NTOK * DM || ws_size < WS_END) { fprintf(stderr, "kernel_launch: unexpected shapes (n_in %d, in0 %d, out %d, ws %zu); nothing launched\n", n_in, n_in > 0 ? in_sizes[0] : -1, out_size, ws_size); grid = -1; return; }
        int dev = 0, cus = 0, per_cu = 0;
        if (hipGetDevice(&dev) != hipSuccess || hipDeviceGetAttribute(&cus, hipDeviceAttributeMultiprocessorCount, dev) != hipSuccess) { grid = -1; return; }
        if (hipFuncSetAttribute((const void*)mega_fwd, hipFuncAttributeMaxDynamicSharedMemorySize, LDS_BYTES) != hipSuccess) { fprintf(stderr, "kernel_launch: hipFuncSetAttribute failed\n"); grid = -1; return; }
        if (hipOccupancyMaxActiveBlocksPerMultiprocessor(&per_cu, (const void*)mega_fwd, NWAVES * 64, LDS_BYTES) != hipSuccess || per_cu < 1) { fprintf(stderr, "kernel_launch: occupancy query says %d\n", per_cu); }
        (void)hipGetLastError();
        grid = cus;
    }
    if (grid < 0) return;
    if (hipMemsetAsync((char*)d_ws + WS_CTL, 0, CTL_ZERO_BYTES, stream) != hipSuccess) return;
    Args a{};
    for (int i = 0; i < 27; ++i) a.in[i] = (const float*)d_in[i];
    a.out = (float*)d_out; a.ws = (unsigned char*)d_ws;
#if MK_N_LAUNCHES == 1
    a.ph_lo = 0; a.ph_hi = NPHASES;
    hipLaunchKernelGGL(mega_fwd, dim3(grid), dim3(NWAVES * 64), LDS_BYTES, stream, a);
#else
    for (int p = 0; p < NPHASES; ++p) { a.ph_lo = p; a.ph_hi = p + 1; hipLaunchKernelGGL(mega_fwd, dim3(grid), dim3(NWAVES * 64), LDS_BYTES, stream, a); }
#endif
}
```
